# Optimizing an MI355X kernel written in HIP

```python
import math
import jax, jax.numpy as jnp
from jax import lax
import numpy as np

D_MODEL = 1024
BATCH = 8
SEQ = 2048
DEPTH = 1
DEC_BATCH = 128
DEC_SEQ = 4
PAST_LEN = 16384
PAGE_SIZE = 128

A_HEADS = 4
A_HEAD_DIM = D_MODEL // (2 * A_HEADS)
A_WIDTH = A_HEADS * A_HEAD_DIM
CHUNK = 128
SSM_WIDTH = D_MODEL - A_WIDTH
SSM_GROUP = 16
SSM_GROUPS = SSM_WIDTH // SSM_GROUP
SSM_STATE = 64
DT_MIN = 1e-3
DT_MAX = 1e-1
D_FF = 11 * D_MODEL // 4
CONV_W = 3
EPS = 1e-6

kernel_name = 'hymba_sgu_s5_convffn_step'


def _rmsnorm(x, g):
    xf = x.astype(jnp.float32)
    xf = xf * lax.rsqrt(jnp.mean(xf * xf, axis=-1, keepdims=True) + EPS)
    return xf.astype(x.dtype) * g


def _chunk_sgu(u, v, w_s, b_s):
    bt, L, H, Dh = v.shape
    w = jnp.tril(w_s)
    if L <= CHUNK:
        s = jnp.einsum('hts,bshd->bthd', w[:, :L, :L], v) + jnp.transpose(b_s[:, :L])[None, :, :, None]
    else:
        n = -(-L // CHUNK)
        vp = jnp.pad(v, ((0, 0), (0, n * CHUNK - L), (0, 0), (0, 0))).reshape(bt, n, CHUNK, H, Dh)
        s = jnp.einsum('hts,bnshd->bnthd', w, vp) + jnp.transpose(b_s)[None, None, :, :, None]
        s = s.reshape(bt, n * CHUNK, H, Dh)[:, :L]
    return u * s


def _cplx_combine(e1, e2):
    a1r, a1i, b1r, b1i = e1
    a2r, a2i, b2r, b2i = e2
    return (a2r * a1r - a2i * a1i,
            a2r * a1i + a2i * a1r,
            a2r * b1r - a2i * b1i + b2r,
            a2r * b1i + a2i * b1r + b2i)


def _ssm_scan(xs, h0_re, h0_im, lam_re, lam_im, log_dt, b_re, b_im, c_re, c_im, d_skip):
    bt, L, _ = xs.shape
    f32 = jnp.float32
    xf = xs.astype(f32).reshape(bt, L, SSM_GROUPS, SSM_GROUP)
    lr = lam_re.astype(f32)
    li = lam_im.astype(f32)
    dt = jnp.exp(log_dt.astype(f32))[:, None]
    mag = jnp.exp(lr * dt)
    ar = mag * jnp.cos(li * dt)
    ai = mag * jnp.sin(li * dt)
    den = lr * lr + li * li
    fr = ((ar - 1.0) * lr + ai * li) / den
    fi = (ai * lr - (ar - 1.0) * li) / den
    bre = b_re.astype(f32)
    bim = b_im.astype(f32)
    bbr = fr[..., None] * bre - fi[..., None] * bim
    bbi = fr[..., None] * bim + fi[..., None] * bre
    ur = jnp.einsum('blgc,gpc->blgp', xf, bbr)
    ui = jnp.einsum('blgc,gpc->blgp', xf, bbi)
    h0r = h0_re.astype(f32)
    h0i = h0_im.astype(f32)
    ur = ur.at[:, 0].add(ar * h0r - ai * h0i)
    ui = ui.at[:, 0].add(ar * h0i + ai * h0r)
    a_r = jnp.broadcast_to(ar, ur.shape)
    a_i = jnp.broadcast_to(ai, ui.shape)
    _, _, hr, hi = lax.associative_scan(_cplx_combine, (a_r, a_i, ur, ui), axis=1)
    y = (jnp.einsum('blgp,gcp->blgc', hr, c_re.astype(f32))
         - jnp.einsum('blgp,gcp->blgc', hi, c_im.astype(f32))
         + d_skip.astype(f32).reshape(SSM_GROUPS, SSM_GROUP) * xf)
    return (y.reshape(bt, L, SSM_WIDTH).astype(xs.dtype),
            hr[:, -1].astype(h0_re.dtype), hi[:, -1].astype(h0_im.dtype))


def _layer(x, h0_re, h0_im, conv_buf, p):
    bt, L, _ = x.shape
    n1 = _rmsnorm(x, p['g_mix'])
    proj = n1 @ p['w_in']
    u, v, xs = jnp.split(proj, [A_WIDTH, 2 * A_WIDTH], axis=-1)
    u = u.reshape(bt, L, A_HEADS, A_HEAD_DIM)
    v = _rmsnorm(v.reshape(bt, L, A_HEADS, A_HEAD_DIM), p['g_v'])
    a_out = _chunk_sgu(u, v, p['w_s'], p['b_s']).reshape(bt, L, A_WIDTH)
    ys, hr, hi = _ssm_scan(xs, h0_re, h0_im, p['lam_re'], p['lam_im'], p['log_dt'],
                           p['b_re'], p['b_im'], p['c_re'], p['c_im'], p['d_skip'])
    g = jax.nn.gelu(ys)
    b_out = g * jax.nn.sigmoid(g @ p['w_glu'] + p['b_glu'])
    mix = jnp.concatenate([_rmsnorm(a_out, p['g_out_a']), _rmsnorm(b_out, p['g_out_b'])], axis=-1)
    h = x + mix @ p['w_out']
    n2 = _rmsnorm(h, p['g_ffn'])
    up = n2 @ p['w_ffn_in']
    padded = jnp.concatenate([conv_buf.astype(up.dtype), up], axis=1)
    conv = p['conv_b'] + sum(p['conv_w'][k] * padded[:, k:k + L] for k in range(CONV_W))
    gate, val = jnp.split(conv, 2, axis=-1)
    h = h + (jax.nn.gelu(gate) * val) @ p['w_ffn_out']
    y = _rmsnorm(h, p['g_final'])
    return y, v, hr, hi, padded[:, -(CONV_W - 1):]


def setup_inputs(seed: int = 0) -> dict:
    key = jax.random.key(seed)
    ks = jax.random.split(key, 32)
    nrm = lambda k, s, sc: jax.random.normal(k, s, jnp.float32) * sc
    d_in = 2 * A_WIDTH + SSM_WIDTH
    lam_im = jnp.float32(math.pi) * jnp.arange(SSM_STATE, dtype=jnp.float32)[None, :] + nrm(ks[11], (SSM_GROUPS, SSM_STATE), 0.01)
    return {
        'x_prompt': nrm(ks[0], (BATCH, SEQ, D_MODEL), 1.0),
        'x_sample': nrm(ks[1], (DEC_BATCH, DEC_SEQ, D_MODEL), 1.0),
        'state_ssm_re': nrm(ks[2], (DEC_BATCH, SSM_GROUPS, SSM_STATE), 0.1),
        'state_ssm_im': nrm(ks[3], (DEC_BATCH, SSM_GROUPS, SSM_STATE), 0.1),
        'state_conv': nrm(ks[4], (DEC_BATCH, CONV_W - 1, 2 * D_FF), 1.0),
        'g_mix': 1.0 + nrm(ks[5], (D_MODEL,), 0.01),
        'w_in': nrm(ks[6], (D_MODEL, d_in), D_MODEL ** -0.5),
        'g_v': 1.0 + nrm(ks[7], (A_HEADS, A_HEAD_DIM), 0.01),
        'w_s': nrm(ks[8], (A_HEADS, CHUNK, CHUNK), CHUNK ** -0.5),
        'b_s': 1.0 + nrm(ks[9], (A_HEADS, CHUNK), 0.01),
        'lam_re': -0.5 + nrm(ks[10], (SSM_GROUPS, SSM_STATE), 0.01),
        'lam_im': lam_im,
        'log_dt': jax.random.uniform(ks[12], (SSM_GROUPS,), jnp.float32, math.log(DT_MIN), math.log(DT_MAX)),
        'b_re': nrm(ks[13], (SSM_GROUPS, SSM_STATE, SSM_GROUP), (2 * SSM_GROUP) ** -0.5),
        'b_im': nrm(ks[14], (SSM_GROUPS, SSM_STATE, SSM_GROUP), (2 * SSM_GROUP) ** -0.5),
        'c_re': nrm(ks[15], (SSM_GROUPS, SSM_GROUP, SSM_STATE), (2 * SSM_STATE) ** -0.5),
        'c_im': nrm(ks[16], (SSM_GROUPS, SSM_GROUP, SSM_STATE), (2 * SSM_STATE) ** -0.5),
        'd_skip': nrm(ks[17], (SSM_WIDTH,), 1.0),
        'w_glu': nrm(ks[18], (SSM_WIDTH, SSM_WIDTH), SSM_WIDTH ** -0.5),
        'b_glu': nrm(ks[19], (SSM_WIDTH,), 0.01),
        'g_out_a': 1.0 + nrm(ks[20], (A_WIDTH,), 0.01),
        'g_out_b': 1.0 + nrm(ks[21], (SSM_WIDTH,), 0.01),
        'w_out': nrm(ks[22], (A_WIDTH + SSM_WIDTH, D_MODEL), (A_WIDTH + SSM_WIDTH) ** -0.5),
        'g_ffn': 1.0 + nrm(ks[23], (D_MODEL,), 0.01),
        'w_ffn_in': nrm(ks[24], (D_MODEL, 2 * D_FF), D_MODEL ** -0.5),
        'conv_w': nrm(ks[25], (CONV_W, 2 * D_FF), CONV_W ** -0.5),
        'conv_b': nrm(ks[26], (2 * D_FF,), 0.01),
        'w_ffn_out': nrm(ks[27], (D_FF, D_MODEL), D_FF ** -0.5),
        'g_final': 1.0 + nrm(ks[28], (D_MODEL,), 0.01),
    }


def reference(x_prompt, x_sample, state_ssm_re, state_ssm_im, state_conv,
              g_mix, w_in, g_v, w_s, b_s, lam_re, lam_im, log_dt, b_re, b_im, c_re, c_im,
              d_skip, w_glu, b_glu, g_out_a, g_out_b, w_out, g_ffn, w_ffn_in, conv_w, conv_b,
              w_ffn_out, g_final):
    p = dict(g_mix=g_mix, w_in=w_in, g_v=g_v, w_s=w_s, b_s=b_s, lam_re=lam_re, lam_im=lam_im,
             log_dt=log_dt, b_re=b_re, b_im=b_im, c_re=c_re, c_im=c_im, d_skip=d_skip,
             w_glu=w_glu, b_glu=b_glu, g_out_a=g_out_a, g_out_b=g_out_b, w_out=w_out,
             g_ffn=g_ffn, w_ffn_in=w_ffn_in, conv_w=conv_w, conv_b=conv_b,
             w_ffn_out=w_ffn_out, g_final=g_final)
    h = x_prompt
    s_re = jnp.zeros((BATCH, SSM_GROUPS, SSM_STATE), state_ssm_re.dtype)
    s_im = jnp.zeros((BATCH, SSM_GROUPS, SSM_STATE), state_ssm_im.dtype)
    c_buf = jnp.zeros((BATCH, CONV_W - 1, 2 * D_FF), state_conv.dtype)
    for _ in range(DEPTH):
        h, _v_p, s_re, s_im, c_buf = _layer(h, s_re, s_im, c_buf, p)
    y_prompt, ssm_re_prompt, ssm_im_prompt, conv_prompt = h, s_re, s_im, c_buf
    h = x_sample
    s_re, s_im, c_buf = state_ssm_re, state_ssm_im, state_conv
    for _ in range(DEPTH):
        h, v_sample, s_re, s_im, c_buf = _layer(h, s_re, s_im, c_buf, p)
    y_sample = h
    return (y_prompt, y_sample, v_sample, ssm_re_prompt, ssm_im_prompt, conv_prompt, s_re, s_im, c_buf)
```

```cpp
#include <hip/hip_runtime.h>
#include <hip/hip_cooperative_groups.h>
#include <cstdio>
#define PH_HI 11
namespace cg = cooperative_groups;

#define LAS __attribute__((address_space(3)))
typedef unsigned short bf16_t;
typedef short bf16x8 __attribute__((ext_vector_type(8)));
typedef float f32x4 __attribute__((ext_vector_type(4)));
typedef unsigned u32x4 __attribute__((ext_vector_type(4)));
typedef unsigned u32x2 __attribute__((ext_vector_type(2)));

constexpr int MTOK = 16896, MPR = 16384, DM = 1024, NPROJ = 1536, FF = 2816, FF2 = 5632;
constexpr int MC16 = 1280, KY = 384;
constexpr float EPS = 1e-6f;
constexpr size_t O_Y = 0, O_VS = 17301504, O_SRP = 17563648, O_SIP = 17580032, O_CP = 17596416, O_SRS = 17686528, O_SIS = 17948672, O_CS = 18210816;
constexpr size_t W_WUP = 0, W_WDN = 11534336, W_HB = 17301504, W_HALO = 51904512, W_UPS = 57851904, W_SSQB = 63619072, W_SSQH = 63686656,
                 W_SSQF = 63754240, W_R1 = 63821824, W_A16 = 63889408, W_AM12 = 63905792, W_SSQA = 63922176, W_BAR = 63989760, W_UP = 64006144;
constexpr size_t W_WIN = W_UP + 0, W_WGLU = W_UP + 3145728, W_WOUT = W_UP + 3670016, W_WTRIL = W_UP + 5767168, W_WY = W_UP + 5898240,
                 W_WE = W_UP + 12189696, W_XB = W_UP + 16384000, W_GB = W_UP + 50987008  , W_U = W_UP + 50987008, W_V = W_UP + 68288512,
                 W_AG = W_UP + 85590016, W_EB = W_UP + 117047296, W_MIX = W_UP + 138018816, W_AOUT = W_UP + 172621824;
constexpr size_t W_ACT = W_UP, W_HEAD = W_UP + 100663296, W_PART = W_UP + 110100480;
constexpr size_t W_END = W_UP + (size_t)MTOK * FF2 * 2;
constexpr int LDS_BYTES = 131072 + 16;

struct Params {
    const float *x_prompt, *x_sample, *st_re, *st_im, *st_conv, *g_mix, *w_in, *g_v, *w_s, *b_s, *lam_re, *lam_im, *log_dt, *b_re, *b_im, *c_re, *c_im,
        *d_skip, *w_glu, *b_glu, *g_out_a, *g_out_b, *w_out, *g_ffn, *w_ffn_in, *conv_w, *conv_b, *w_ffn_out, *g_final;
    float* out; unsigned char* ws; int ph_lo, ph_hi;
};
typedef const __attribute__((address_space(4))) Params* KP;
#define p (*kp)

__device__ __forceinline__ unsigned short f2bf(float f) { unsigned u = __float_as_uint(f); u += 0x7FFFu + ((u >> 16) & 1u); return (unsigned short)(u >> 16); }
__device__ __forceinline__ float bflo(unsigned w) { return __uint_as_float(w << 16); }
__device__ __forceinline__ float bfhi(unsigned w) { return __uint_as_float(w & 0xffff0000u); }
__device__ __forceinline__ unsigned pk2(float lo, float hi) { return (unsigned)f2bf(lo) | ((unsigned)f2bf(hi) << 16); }
__device__ __forceinline__ float gelu_t(float x) { const float z = -2.3022082f * (x + 0.044715f * x * x * x); return x * __builtin_amdgcn_rcpf(1.0f + __builtin_amdgcn_exp2f(z)); }
__device__ __forceinline__ float sigm(float x) { return __builtin_amdgcn_rcpf(1.0f + __builtin_amdgcn_exp2f(-1.44269504f * x)); }
template <int CTRL> __device__ __forceinline__ float dpps(float old, float v) { return __int_as_float(__builtin_amdgcn_update_dpp(__float_as_int(old), __float_as_int(v), CTRL, 0xf, 0xf, false)); }
template <int CTRL> __device__ __forceinline__ float dppf(float v) { return __int_as_float(__builtin_amdgcn_update_dpp(0, __float_as_int(v), CTRL, 0xf, 0xf, false)); }


#define XB_TMO      128
#define XB_XCNT(j)  (256  + 64 * (j))
#define XB_XSUB(j)  (1280 + 64 * (j))
#define XB_XGEN(j)  (2304 + 64 * (j))
#define XB_TOP      3328
#define XB_TOPGEN   3392
#define XCD_BAR_WORDS 3456
#define XB_SPIN_CAP (1u << 18)
__device__ __forceinline__ unsigned xb_ld(unsigned* q)              { return __hip_atomic_load(q, __ATOMIC_RELAXED, __HIP_MEMORY_SCOPE_AGENT); }
__device__ __forceinline__ unsigned xb_add(unsigned* q, unsigned v) { return __hip_atomic_fetch_add(q, v, __ATOMIC_RELAXED, __HIP_MEMORY_SCOPE_AGENT); }
__device__ __forceinline__ unsigned xb_xcc_id() { return (unsigned)__builtin_amdgcn_s_getreg((3 << 11) | 20) & 0xFu; }
#define XB_SPIN(cond, bar) do { unsigned _sp = 0; while (cond) { __builtin_amdgcn_s_sleep(1); \
    if ((++_sp & 255u) == 0u) { if (xb_ld(&(bar)[XB_TMO])) break; if (_sp > XB_SPIN_CAP) { atomicAdd(&(bar)[XB_TMO], 1u); break; } } } } while (0)
__device__ __forceinline__ void xcd_barrier_complete(unsigned* bar, unsigned x, unsigned& nloc, unsigned& nx) {
    const unsigned G = gridDim.x;
    unsigned sum, cnt, mine, sp = 0u;
    for (;;) {
        sum = 0u; cnt = 0u; mine = 0u;
#pragma unroll
        for (unsigned j = 0; j < 16; ++j) { const unsigned c = xb_ld(&bar[XB_XCNT(j)]); sum += c; cnt += (c > 0u) ? 1u : 0u; mine = (j == x) ? c : mine; }
        if (sum == G) break;
        __builtin_amdgcn_s_sleep(1);
        if ((++sp & 255u) == 0u) { if (xb_ld(&bar[XB_TMO])) break; if (sp > XB_SPIN_CAP) { atomicAdd(&bar[XB_TMO], 1u); break; } }
    }
    nloc = mine > 0u ? mine : 1u; nx = cnt > 0u ? cnt : 1u;
}
__device__ __forceinline__ void xcd_barrier(unsigned* bar, volatile LAS unsigned* st) {
    asm volatile("s_waitcnt vmcnt(0)" ::: "memory");
    __syncthreads();
    if (threadIdx.x == 0) {
        __builtin_amdgcn_s_waitcnt(0);
        const unsigned x = xb_xcc_id();
        unsigned nloc = st[0], nx = st[1];
        if (nloc == 0u) { xcd_barrier_complete(bar, x, nloc, nx); st[0] = nloc; st[1] = nx; }
        const unsigned old = xb_add(&bar[XB_XSUB(x)], 1u);
        const unsigned gen = old / nloc;
        if (old + 1u == (gen + 1u) * nloc) {
            __builtin_amdgcn_fence(__ATOMIC_RELEASE, "agent");
            asm volatile("s_waitcnt vmcnt(0)" ::: "memory");
            const unsigned og = xb_add(&bar[XB_TOP], 1u);
            const unsigned tg = og / nx;
            if (og + 1u == (tg + 1u) * nx) xb_add(&bar[XB_TOPGEN], 1u);
            else XB_SPIN(xb_ld(&bar[XB_TOPGEN]) == tg, bar);
            __builtin_amdgcn_fence(__ATOMIC_ACQUIRE, "agent");
            xb_add(&bar[XB_XGEN(x)], 1u);
            asm volatile("s_waitcnt vmcnt(0)" ::: "memory");
        } else {
            XB_SPIN(xb_ld(&bar[XB_XGEN(x)]) == gen, bar);
            __builtin_amdgcn_fence(__ATOMIC_ACQUIRE, "agent");
            asm volatile("s_waitcnt vmcnt(0)" ::: "memory");
        }
    }
    __syncthreads();
}

namespace pg8 {
constexpr int BM = 256, BK = 64, HALF = 128, HTB = HALF * BK * 2, STAGE_BYTES = 8 * HTB, NXCD = 8, WGM = 8;
__device__ __forceinline__ int lds_byte(int r, int c) { const int st = (r >> 4) * 2 + (c >> 5), rr = r & 15, cc = c & 31, ob = rr * 64 + cc * 2; return st * 1024 + (ob ^ (((ob >> 9) & 1) << 5)); }
__device__ __forceinline__ void stage_rc(int b, int& R, int& C) { const int st = b / 1024, sb = b % 1024, swz = sb ^ (((sb >> 9) & 1) << 5); R = (st >> 1) * 16 + swz / 64; C = (st & 1) * 32 + (swz % 64) / 2; }
__device__ __forceinline__ int perm32(int rho) { const int n = rho >> 4, i = rho & 15; return 8 * (i >> 2) + 4 * n + (i & 3); }
struct Unit { int pm, pn, k0, nt; };
struct Gemm { const bf16_t* A; const bf16_t* Bt; int lda, ldb; size_t kstepA, kstepB, tstepA, tstepB; };
__device__ __forceinline__ Gemm gemm_rm(const bf16_t* A, const bf16_t* Bt, int lda, int ldb) { return Gemm{A, Bt, lda, ldb, 128, 128, (size_t)512 * lda, (size_t)512 * ldb}; }
struct StaticOrder {
    int nM, nN, nwg, G, c, ntK;
    __device__ void init(int M, int N, int K, int G_, int c_) { nM = M / BM; nN = N / BM; nwg = nM * nN; G = G_; c = c_; ntK = K / BK; }
    __device__ bool next(int i, Unit& u) const {
        const long L = (long)i * G + c; if (L >= nwg) return false;
        int wgid = (int)L; { const int q = nwg / NXCD, r = nwg % NXCD, xcd = wgid % NXCD, off = wgid / NXCD; wgid = (xcd < r ? xcd * (q + 1) : r * (q + 1) + (xcd - r) * q) + off; }
        const int nig = WGM * nN, gid = wgid / nig, fm = gid * WGM, gsz = (nM - fm) < WGM ? (nM - fm) : WGM;
        u.pm = fm + ((wgid % nig) % gsz); u.pn = (wgid % nig) / gsz; u.k0 = 0; u.nt = ntK; return true;
    }
};
struct BatchedOrder {
    int nu, per, G, c, ntK;
    __device__ bool next(int i, Unit& u) const { int L = i * G + c; if (L >= nu) return false;
        if (G == 256 && nu == 160 && per == 5) { const int x = c & 7, slot = c >> 3; L = (4 * x + slot / 5) * 5 + slot % 5; }
        u.pm = L; u.pn = L / per; u.k0 = 0; u.nt = ntK; return true; }
};
struct SplitOrder {
    StaticOrder S0; int nN, nch, pm0;
    __device__ void init(int Mmain, int N, int K, int G_, int c_) { S0.init(Mmain, N, K, G_, c_); nN = N / BM; nch = K / 256; pm0 = Mmain / BM; }
    __device__ bool next(int i, Unit& u) const {
        if (S0.next(i, u)) return true;
        const int R = ((S0.nwg + S0.G - 1) / S0.G) * S0.G, s = i * S0.G + S0.c - R;
        if (s < 0 || s >= 2 * nN * nch) return false;
        u.pm = pm0 + s / (nN * nch); u.pn = (s / nch) % nN; u.k0 = (s % nch) * 256; u.nt = 4; return true;
    }
};
__device__ __forceinline__ unsigned cvt_pk_bf16(float lo, float hi) { unsigned r; asm volatile("v_cvt_pk_bf16_f32 %0, %1, %2" : "=v"(r) : "v"(lo), "v"(hi)); return r; }
struct NoMid { static constexpr bool ON = false; __device__ __forceinline__ void operator()(f32x4 (&)[2][2][4][2], const Unit&, int, int) const {} };

template <class Epi, class Sched, class Mid>
__device__ __forceinline__ void gemm_phase(LAS unsigned char* lds, const Gemm g, const Sched& S, const Epi& E, const Mid& MD) {
    const int tid = threadIdx.x, wid = __builtin_amdgcn_readfirstlane(tid >> 6), lane = tid & 63, wr = wid >> 2, wc = wid & 3, fr = lane & 15, fq = lane >> 4;
    unsigned voffA[2], voffB[2];
#pragma unroll
    for (int i = 0; i < 2; ++i) { int R, C; stage_rc(tid * 16 + i * 8192, R, C); const int Rb = Epi::PERM ? ((R & ~31) + perm32(R & 31)) : R;
        voffA[i] = (unsigned)(R * g.lda + C) * 2u; voffB[i] = (unsigned)(Rb * g.ldb + C) * 2u; }
    const size_t kstepA = g.kstepA, kstepB = g.kstepB;
    const size_t hstepA = (size_t)HALF * g.lda * 2, hstepB = (size_t)HALF * g.ldb * 2;
    const size_t tstepA = g.tstepA, tstepB = g.tstepB;
    const unsigned ldsw = (unsigned)wid * 1024u;
    const int aoff = lds_byte(wr * 64 + fr, fq * 8), boff = lds_byte(wc * 32 + fr, fq * 8);
#define PG8_SA(b, h) (((b) * 2 + (h)) * HTB)
#define PG8_SB(b, h) ((4 + (b) * 2 + (h)) * HTB)
#define PG8_STAGE(bufoff, gbase, voff) do { _Pragma("unroll") for (int _i = 0; _i < 2; ++_i) \
        __builtin_amdgcn_global_load_lds((const unsigned*)((const char*)(gbase) + (voff)[_i]), (LAS unsigned*)(lds + (bufoff) + ldsw + _i * 8192), 16, 0, 0); } while (0)
#define PG8_LDA(dst, b, h) do { _Pragma("unroll") for (int m = 0; m < 4; ++m) _Pragma("unroll") for (int k = 0; k < 2; ++k) dst[m][k] = *(const LAS bf16x8*)(lds + PG8_SA(b, h) + aoff + m * 2048 + k * 1024); } while (0)
#define PG8_LDB(dst, b, h) do { _Pragma("unroll") for (int n = 0; n < 2; ++n) _Pragma("unroll") for (int k = 0; k < 2; ++k) dst[n][k] = *(const LAS bf16x8*)(lds + PG8_SB(b, h) + boff + n * 2048 + k * 1024); } while (0)
#define PG8_MMA(ai, bj, At, Bt) do { __builtin_amdgcn_s_setprio(1); _Pragma("unroll") for (int m = 0; m < 4; ++m) _Pragma("unroll") for (int n = 0; n < 2; ++n) _Pragma("unroll") for (int k = 0; k < 2; ++k) \
        acc[ai][bj][m][n] = __builtin_amdgcn_mfma_f32_16x16x32_bf16(Bt[n][k], At[m][k], acc[ai][bj][m][n], 0, 0, 0); __builtin_amdgcn_s_setprio(0); } while (0)
#define PG8_WAIT_V(n) asm volatile("s_waitcnt vmcnt(" #n ")" ::: "memory")
#define PG8_WAIT_L(n) asm volatile("s_waitcnt lgkmcnt(" #n ")" ::: "memory")
#define PG8_BAR __builtin_amdgcn_s_barrier()
#define PG8_SCHED __builtin_amdgcn_sched_barrier(0)
    Unit cur, nxt; int ui = 0;
    if (!S.next(0, cur)) return;
    f32x4 acc[2][2][4][2];
#pragma unroll
    for (int a = 0; a < 2; ++a)
#pragma unroll
        for (int b = 0; b < 2; ++b)
#pragma unroll
            for (int m = 0; m < 4; ++m)
#pragma unroll
                for (int n = 0; n < 2; ++n) acc[a][b][m][n] = (f32x4){0.f, 0.f, 0.f, 0.f};
    bf16x8 At[4][2], B0[2][2], B1[2][2];
    const char* cA = (const char*)g.A + (size_t)cur.pm * tstepA + (size_t)(cur.k0 >> 6) * kstepA; const char* cB = (const char*)g.Bt + (size_t)cur.pn * tstepB + (size_t)(cur.k0 >> 6) * kstepB;
    PG8_STAGE(PG8_SB(0, 0), cB, voffB); PG8_STAGE(PG8_SA(0, 0), cA, voffA); PG8_STAGE(PG8_SB(0, 1), cB + hstepB, voffB); PG8_STAGE(PG8_SA(0, 1), cA + hstepA, voffA);
    if (wr == 1) PG8_BAR;
    PG8_WAIT_V(4); PG8_BAR;
    PG8_STAGE(PG8_SB(1, 0), cB + kstepB, voffB); PG8_STAGE(PG8_SA(1, 0), cA + kstepA, voffA); PG8_STAGE(PG8_SB(1, 1), cB + hstepB + kstepB, voffB);
    PG8_WAIT_V(6); PG8_BAR;
    for (;;) {
        const bool has_next = S.next(ui + 1, nxt);
        const char* nA = has_next ? (const char*)g.A + (size_t)nxt.pm * tstepA + (size_t)(nxt.k0 >> 6) * kstepA : cA; const char* nB = has_next ? (const char*)g.Bt + (size_t)nxt.pn * tstepB + (size_t)(nxt.k0 >> 6) * kstepB : cB;
        const int nt = cur.nt;
        for (int t = 0; t < nt; t += 2) {
            const bool last = (t == nt - 2);
            if constexpr (Mid::ON) { if (t == (nt >> 1)) MD(acc, cur, wr, fr); }
            const char* a1 = cA + (size_t)(t + 1) * kstepA;
            const char* a2 = last ? nA : cA + (size_t)(t + 2) * kstepA; const char* b2 = last ? nB : cB + (size_t)(t + 2) * kstepB;
            const char* a3 = a2 + kstepA; const char* b3 = b2 + kstepB;
            PG8_LDB(B0, 0, 0); PG8_SCHED; PG8_LDA(At, 0, 0); PG8_STAGE(PG8_SA(1, 1), a1 + hstepA, voffA);
            PG8_WAIT_L(8); PG8_BAR; PG8_WAIT_L(0); PG8_MMA(0, 0, At, B0); PG8_BAR; PG8_SCHED;
            PG8_LDB(B1, 0, 1); PG8_STAGE(PG8_SB(0, 0), b2, voffB);
            PG8_BAR; PG8_WAIT_L(0); PG8_MMA(0, 1, At, B1); PG8_BAR;
            PG8_LDA(At, 0, 1); PG8_STAGE(PG8_SA(0, 0), a2, voffA);
            PG8_BAR; PG8_WAIT_L(0); PG8_MMA(1, 0, At, B0); PG8_BAR; PG8_SCHED;
            PG8_STAGE(PG8_SB(0, 1), b2 + hstepB, voffB);
            PG8_WAIT_V(6); PG8_BAR; PG8_MMA(1, 1, At, B1); PG8_BAR;
            PG8_LDB(B0, 1, 0); PG8_SCHED; PG8_LDA(At, 1, 0); PG8_STAGE(PG8_SA(0, 1), a2 + hstepA, voffA);
            PG8_WAIT_L(8); PG8_BAR; PG8_WAIT_L(0); PG8_MMA(0, 0, At, B0); PG8_BAR; PG8_SCHED;
            PG8_LDB(B1, 1, 1); PG8_STAGE(PG8_SB(1, 0), b3, voffB);
            PG8_BAR; PG8_WAIT_L(0); PG8_MMA(0, 1, At, B1); PG8_BAR;
            PG8_LDA(At, 1, 1); PG8_STAGE(PG8_SA(1, 0), a3, voffA);
            PG8_BAR; PG8_WAIT_L(0); PG8_MMA(1, 0, At, B0); PG8_BAR; PG8_SCHED;
            PG8_STAGE(PG8_SB(1, 1), b3 + hstepB, voffB);
            PG8_WAIT_V(6); PG8_BAR; PG8_MMA(1, 1, At, B1); PG8_BAR;
        }
        E(acc, cur, wr, wc, fr, fq);
        if (!has_next) break;
#pragma unroll
        for (int a = 0; a < 2; ++a)
#pragma unroll
            for (int b = 0; b < 2; ++b)
#pragma unroll
                for (int m = 0; m < 4; ++m)
#pragma unroll
                    for (int n = 0; n < 2; ++n) acc[a][b][m][n] = (f32x4){0.f, 0.f, 0.f, 0.f};
        cur = nxt; cA = nA; cB = nB; ++ui;
    }
    PG8_WAIT_V(0);
    if (wr == 0) PG8_BAR;
    PG8_BAR;
#undef PG8_SA
#undef PG8_SB
#undef PG8_STAGE
#undef PG8_LDA
#undef PG8_LDB
#undef PG8_MMA
#undef PG8_WAIT_V
#undef PG8_WAIT_L
#undef PG8_BAR
#undef PG8_SCHED
}
}
using pg8::Unit;
typedef f32x4 Acc[2][2][4][2];
__device__ __forceinline__ size_t act_off(int r, int j) { return ((size_t)((r >> 8) * (FF / 64) + (j >> 6)) * 256 + (r & 255)) * 64 + (j & 63); }

struct EpiProj { static constexpr bool PERM = true; const float* r1; bf16_t* U; bf16_t* V; bf16_t* AG;
    __device__ __forceinline__ void operator()(const Acc& acc, const Unit& u, int wr, int wc, int fr, int fq) const {
        const int row0 = u.pm * 256 + wr * 64 + fr, colt = u.pn * 256 + wc * 32 + 8 * fq;
#pragma unroll
        for (int ai = 0; ai < 2; ++ai)
#pragma unroll
            for (int m = 0; m < 4; ++m) { const int r = row0 + ai * 128 + m * 16; const float s = r1[r];
#pragma unroll
                for (int bj = 0; bj < 2; ++bj) { const int c = colt + bj * 128; const f32x4 v0 = acc[ai][bj][m][0] * s, v1 = acc[ai][bj][m][1] * s;
                    u32x4 w; w.x = pg8::cvt_pk_bf16(v0[0], v0[1]); w.y = pg8::cvt_pk_bf16(v0[2], v0[3]); w.z = pg8::cvt_pk_bf16(v1[0], v1[1]); w.w = pg8::cvt_pk_bf16(v1[2], v1[3]);
                    bf16_t* dst;
                    if (u.pn < 2) dst = U + (size_t)r * 512 + c;
                    else if (u.pn < 4) dst = V + (size_t)r * 512 + (c - 512);
                    else { const int ch = c - 1024, gg = ch >> 4, ci0 = ch & 15; int c16, t; if (r < MPR) { c16 = r >> 4; t = r & 15; } else { c16 = 1024 + ((r - MPR) >> 2); t = 12 + (r & 3); }
                        dst = AG + ((size_t)(gg * MC16 + c16) * KY + t * 16 + ci0); }
                    *(u32x4*)dst = w; } }
    }
};
struct EpiE { static constexpr bool PERM = false; float* EB;
    __device__ __forceinline__ void operator()(const Acc& acc, const Unit& u, int wr, int wc, int fr, int fq) const {
        const int row0 = u.pm * 256 + wr * 64 + fr, col0 = wc * 32 + 4 * fq;
#pragma unroll
        for (int ai = 0; ai < 2; ++ai)
#pragma unroll
            for (int m = 0; m < 4; ++m) { float* rp = EB + (size_t)(row0 + ai * 128 + m * 16) * 128 + col0;
#pragma unroll
                for (int n = 0; n < 2; ++n) *(f32x4*)(rp + n * 16) = acc[ai][0][m][n]; }
    }
};
struct EpiY { static constexpr bool PERM = true; const bf16_t* AG; const float* dsk; bf16_t* GB;
    __device__ __forceinline__ void operator()(const Acc& acc, const Unit& u, int wr, int wc, int fr, int fq) const {
        asm volatile("" : "+v"(fr), "+v"(fq));
        const int gg = u.pn, row0 = u.pm * 256 + wr * 64 + fr, colt = wc * 32 + 8 * fq;
#pragma unroll
        for (int ai = 0; ai < 2; ++ai)
#pragma unroll
            for (int m = 0; m < 4; ++m) { const int r = row0 + ai * 128 + m * 16, c16 = r - gg * MC16;
#pragma unroll
                for (int bj = 0; bj < 2; ++bj) { const int cb = colt + bj * 128, t = cb >> 4, co0 = cb & 15;
                    int tok = -1; if (c16 < 1024) tok = c16 * 16 + t; else if (c16 < 1152 && t >= 12) tok = MPR + (c16 - 1024) * 4 + (t - 12);
                    if (tok >= 0) {
                        const u32x4 xw = *(const u32x4*)(AG + (size_t)r * KY + cb);
                        u32x4 w;
                        { const f32x4 d0 = *(const f32x4*)(dsk + gg * 16 + co0); const f32x4 a0 = acc[ai][bj][m][0];
                          w.x = pg8::cvt_pk_bf16(gelu_t(a0[0] + d0[0] * bflo(xw.x)), gelu_t(a0[1] + d0[1] * bfhi(xw.x))); w.y = pg8::cvt_pk_bf16(gelu_t(a0[2] + d0[2] * bflo(xw.y)), gelu_t(a0[3] + d0[3] * bfhi(xw.y))); }
                        { const f32x4 d1 = *(const f32x4*)(dsk + gg * 16 + co0 + 4); const f32x4 a1 = acc[ai][bj][m][1];
                          w.z = pg8::cvt_pk_bf16(gelu_t(a1[0] + d1[0] * bflo(xw.z)), gelu_t(a1[1] + d1[1] * bfhi(xw.z))); w.w = pg8::cvt_pk_bf16(gelu_t(a1[2] + d1[2] * bflo(xw.w)), gelu_t(a1[3] + d1[3] * bfhi(xw.w))); }
                        *(u32x4*)(GB + (size_t)tok * 512 + gg * 16 + co0) = w; } }
                asm volatile("" ::: "memory"); }
    }
};
struct EpiGlu { static constexpr bool PERM = true; const bf16_t* GB; const float* bglu; bf16_t* MIX; float* ssq;
    __device__ __forceinline__ void operator()(const Acc& acc, const Unit& u, int wr, int wc, int fr, int fq) const {
        const int row0 = u.pm * 256 + wr * 64 + fr, colt = u.pn * 256 + wc * 32 + 8 * fq;
#pragma unroll
        for (int ai = 0; ai < 2; ++ai)
#pragma unroll
            for (int m = 0; m < 4; ++m) { const int r = row0 + ai * 128 + m * 16; float sq = 0.f;
#pragma unroll
                for (int bj = 0; bj < 2; ++bj) { const int c = colt + bj * 128;
                    const u32x4 gw = *(const u32x4*)(GB + (size_t)r * 512 + c);
                    const f32x4 b0 = *(const f32x4*)(bglu + c), b1 = *(const f32x4*)(bglu + c + 4);
                    const f32x4 a0 = acc[ai][bj][m][0] + b0, a1 = acc[ai][bj][m][1] + b1;
                    float o[8]; o[0] = bflo(gw.x) * sigm(a0[0]); o[1] = bfhi(gw.x) * sigm(a0[1]); o[2] = bflo(gw.y) * sigm(a0[2]); o[3] = bfhi(gw.y) * sigm(a0[3]);
                    o[4] = bflo(gw.z) * sigm(a1[0]); o[5] = bfhi(gw.z) * sigm(a1[1]); o[6] = bflo(gw.w) * sigm(a1[2]); o[7] = bfhi(gw.w) * sigm(a1[3]);
#pragma unroll
                    for (int e = 0; e < 8; ++e) sq += o[e] * o[e];
                    u32x4 w; w.x = pg8::cvt_pk_bf16(o[0], o[1]); w.y = pg8::cvt_pk_bf16(o[2], o[3]); w.z = pg8::cvt_pk_bf16(o[4], o[5]); w.w = pg8::cvt_pk_bf16(o[6], o[7]);
                    *(u32x4*)(MIX + (size_t)r * 1024 + c) = w; }
                sq += __shfl_xor(sq, 16); sq += __shfl_xor(sq, 32);
                if (fq == 0) atomicAdd(ssq + r, sq); }
    }
};
struct MidOut { static constexpr bool ON = true; const float* ssqb;
    __device__ __forceinline__ void operator()(Acc& acc, const Unit& u, int wr, int fr) const {
        if (u.nt != 16) return;
        const int row0 = u.pm * 256 + wr * 64 + fr;
#pragma unroll
        for (int ai = 0; ai < 2; ++ai)
#pragma unroll
            for (int m = 0; m < 4; ++m) { const float s = rsqrtf(ssqb[row0 + ai * 128 + m * 16] * (1.0f / 512.0f) + EPS);
#pragma unroll
                for (int bj = 0; bj < 2; ++bj)
#pragma unroll
                    for (int n = 0; n < 2; ++n) acc[ai][bj][m][n] *= s; }
    }
};
struct EpiOut { static constexpr bool PERM = true; const float* xp; const float* xs; float* H; bf16_t* HB; float* ssq; const float* ssqb; float* PART; const bf16_t* XB;
    __device__ __forceinline__ void operator()(const Acc& acc, const Unit& u, int wr, int wc, int fr, int fq) const {
        const int row0 = u.pm * 256 + wr * 64 + fr, colt = u.pn * 256 + wc * 32 + 8 * fq;
        if (u.nt != 16) {
#pragma unroll
            for (int ai = 0; ai < 2; ++ai)
#pragma unroll
                for (int m = 0; m < 4; ++m) { const int r = row0 + ai * 128 + m * 16; const float s = (u.k0 < 512) ? rsqrtf(ssqb[r] * (1.0f / 512.0f) + EPS) : 1.0f;
#pragma unroll
                    for (int bj = 0; bj < 2; ++bj) { float* q = PART + ((size_t)(u.k0 >> 8) * 512 + (r - MPR)) * 1024 + colt + bj * 128;
                        *(f32x4*)q = acc[ai][bj][m][0] * s; *(f32x4*)(q + 4) = acc[ai][bj][m][1] * s; } }
            return;
        }
#pragma unroll
        for (int ai = 0; ai < 2; ++ai)
#pragma unroll
            for (int m = 0; m < 4; ++m) { const int r = row0 + ai * 128 + m * 16; float sq = 0.f;
#pragma unroll
                for (int bj = 0; bj < 2; ++bj) { const int c = colt + bj * 128;
                    const u32x4 xw = *(const u32x4*)(XB + (size_t)r * 1024 + c);
                    const f32x4 h0 = (f32x4){bflo(xw.x), bfhi(xw.x), bflo(xw.y), bfhi(xw.y)} + acc[ai][bj][m][0], h1 = (f32x4){bflo(xw.z), bfhi(xw.z), bflo(xw.w), bfhi(xw.w)} + acc[ai][bj][m][1];
                    sq += h0[0] * h0[0] + h0[1] * h0[1] + h0[2] * h0[2] + h0[3] * h0[3] + h1[0] * h1[0] + h1[1] * h1[1] + h1[2] * h1[2] + h1[3] * h1[3];
                    u32x4 w; w.x = pg8::cvt_pk_bf16(h0[0], h0[1]); w.y = pg8::cvt_pk_bf16(h0[2], h0[3]); w.z = pg8::cvt_pk_bf16(h1[0], h1[1]); w.w = pg8::cvt_pk_bf16(h1[2], h1[3]);
                    *(u32x4*)(HB + (size_t)r * 1024 + c) = w; }
                sq += __shfl_xor(sq, 16); sq += __shfl_xor(sq, 32);
                if (fq == 0) atomicAdd(ssq + r, sq); }
    }
};
struct EpiUp { static constexpr bool PERM = true; const float* ssqh; bf16_t* ACT; bf16_t* HALO; bf16_t* HEAD; bf16_t* UPS; float* out; const float* cw; const float* cb;
    __device__ __forceinline__ void operator()(Acc& acc, const Unit& u, int wr, int wc, int fr, int fq) const {
        const int row0 = u.pm * 256 + wr * 64 + fr, j0 = u.pn * 128 + wc * 32 + 8 * fq;
#pragma unroll
        for (int ai = 0; ai < 2; ++ai)
#pragma unroll
            for (int m = 0; m < 4; ++m) { const float s = rsqrtf(ssqh[row0 + ai * 128 + m * 16] * (1.0f / 1024.0f) + EPS);
#pragma unroll
                for (int bj = 0; bj < 2; ++bj)
#pragma unroll
                    for (int n = 0; n < 2; ++n) acc[ai][bj][m][n] *= s; }
        if (u.pm >= 64) {
#pragma unroll
            for (int ai = 0; ai < 2; ++ai)
#pragma unroll
                for (int m = 0; m < 4; ++m) { const int rs = row0 + ai * 128 + m * 16 - MPR, j = rs & 3;
#pragma unroll
                    for (int bj = 0; bj < 2; ++bj) { const f32x4 v0 = acc[ai][bj][m][0], v1 = acc[ai][bj][m][1]; const int c = bj * FF + j0;
                        u32x4 w; w.x = pg8::cvt_pk_bf16(v0[0], v0[1]); w.y = pg8::cvt_pk_bf16(v0[2], v0[3]); w.z = pg8::cvt_pk_bf16(v1[0], v1[1]); w.w = pg8::cvt_pk_bf16(v1[2], v1[3]);
                        *(u32x4*)(UPS + (size_t)rs * FF2 + c) = w;
                        if (j >= 2) { float* o = out + O_CS + ((size_t)((rs >> 2) * 2 + (j - 2))) * FF2 + c; *(f32x4*)o = v0; *(f32x4*)(o + 4) = v1; } } }
            return;
        }
#pragma unroll
        for (int ai = 0; ai < 2; ++ai) { const int rb = row0 + ai * 128;
            if (fr >= 14) { const int r = rb + 48, k = r >> 6, pos = r & 2047;
#pragma unroll
                for (int bj = 0; bj < 2; ++bj) { const f32x4 v0 = acc[ai][bj][3][0], v1 = acc[ai][bj][3][1]; const int c = bj * FF + j0;
                    u32x4 w; w.x = pg8::cvt_pk_bf16(v0[0], v0[1]); w.y = pg8::cvt_pk_bf16(v0[2], v0[3]); w.z = pg8::cvt_pk_bf16(v1[0], v1[1]); w.w = pg8::cvt_pk_bf16(v1[2], v1[3]);
                    *(u32x4*)(HALO + (size_t)(k * 2 + (fr - 14)) * FF2 + c) = w;
                    if (pos >= 2046) { float* o = out + O_CP + ((size_t)((r >> 11) * 2 + (pos - 2046))) * FF2 + c; *(f32x4*)o = v0; *(f32x4*)(o + 4) = v1; } } }
            if (fr < 2) { const int k = rb >> 6;
#pragma unroll
                for (int bj = 0; bj < 2; ++bj) { const f32x4 v0 = acc[ai][bj][0][0], v1 = acc[ai][bj][0][1]; const int c = bj * FF + j0;
                    u32x4 w; w.x = pg8::cvt_pk_bf16(v0[0], v0[1]); w.y = pg8::cvt_pk_bf16(v0[2], v0[3]); w.z = pg8::cvt_pk_bf16(v1[0], v1[1]); w.w = pg8::cvt_pk_bf16(v1[2], v1[3]);
                    *(u32x4*)(HEAD + (size_t)(k * 2 + fr) * FF2 + c) = w; } } }
        u32x2 keep[2][4];
#pragma unroll
        for (int n = 0; n < 2; ++n) { const int j = j0 + 4 * n;
            const f32x4 wg0 = *(const f32x4*)(cw + j), wg1 = *(const f32x4*)(cw + FF2 + j), wg2 = *(const f32x4*)(cw + 2 * FF2 + j), bg = *(const f32x4*)(cb + j);
            const f32x4 wv0 = *(const f32x4*)(cw + FF + j), wv1 = *(const f32x4*)(cw + FF2 + FF + j), wv2 = *(const f32x4*)(cw + 2 * FF2 + FF + j), bv = *(const f32x4*)(cb + FF + j);
#pragma unroll
            for (int ai = 0; ai < 2; ++ai)
#pragma unroll
                for (int m = 0; m < 4; ++m) { const f32x4 cg = acc[ai][0][m][n], cv = acc[ai][1][m][n];
                    const f32x4 pg = acc[ai][0][m > 0 ? m - 1 : 0][n], pv = acc[ai][1][m > 0 ? m - 1 : 0][n];
                    f32x4 g1, g2, v1, v2;
#pragma unroll
                    for (int e = 0; e < 4; ++e) {
                        g1[e] = dpps<0x111>(dppf<0x121>(pg[e]), cg[e]); g2[e] = dpps<0x112>(dppf<0x122>(pg[e]), cg[e]);
                        v1[e] = dpps<0x111>(dppf<0x121>(pv[e]), cv[e]); v2[e] = dpps<0x112>(dppf<0x122>(pv[e]), cv[e]); }
                    const f32x4 ga = bg + wg0 * g2 + wg1 * g1 + wg2 * cg, va = bv + wv0 * v2 + wv1 * v1 + wv2 * cv;
                    const f32x4 zz = (ga + ga * ga * ga * 0.044715f) * (-2.3022082f);
                    f32x4 o;
#pragma unroll
                    for (int e = 0; e < 4; ++e) o[e] = __builtin_amdgcn_rcpf(1.0f + __builtin_amdgcn_exp2f(zz[e]));
                    o = o * ga * va;
                    u32x2 w; w.x = pg8::cvt_pk_bf16(o[0], o[1]); w.y = pg8::cvt_pk_bf16(o[2], o[3]);
                    if (n == 0) keep[ai][m] = w;
                    else { u32x4 w4; w4.x = keep[ai][m].x; w4.y = keep[ai][m].y; w4.z = w.x; w4.w = w.y; *(u32x4*)(ACT + act_off(row0 + ai * 128 + m * 16, j0)) = w4; asm volatile("" ::: "memory"); } } }
    }
};
struct EpiDown { static constexpr bool PERM = true; float* H; float* ssq; const bf16_t* HB; float* PART; bf16_t* HBW;
    __device__ __forceinline__ void operator()(const Acc& acc, const Unit& u, int wr, int wc, int fr, int fq) const {
        const int row0 = u.pm * 256 + wr * 64 + fr, colt = u.pn * 256 + wc * 32 + 8 * fq;
        const bool partial = (u.nt != FF / 64);
#pragma unroll
        for (int ai = 0; ai < 2; ++ai)
#pragma unroll
            for (int m = 0; m < 4; ++m) { const int r = row0 + ai * 128 + m * 16; float sq = 0.f;
#pragma unroll
                for (int bj = 0; bj < 2; ++bj) { const int c = colt + bj * 128; f32x4 h0 = acc[ai][bj][m][0], h1 = acc[ai][bj][m][1];
                    if (!partial || u.k0 == 0) { const u32x4 hw = *(const u32x4*)(HB + (size_t)r * 1024 + c);
                        h0 += (f32x4){bflo(hw.x), bfhi(hw.x), bflo(hw.y), bfhi(hw.y)}; h1 += (f32x4){bflo(hw.z), bfhi(hw.z), bflo(hw.w), bfhi(hw.w)}; }
                    if (partial) { float* q = PART + ((size_t)(u.k0 >> 8) * 512 + (r - MPR)) * 1024 + c; *(f32x4*)q = h0; *(f32x4*)(q + 4) = h1; }
                    else { sq += h0[0] * h0[0] + h0[1] * h0[1] + h0[2] * h0[2] + h0[3] * h0[3] + h1[0] * h1[0] + h1[1] * h1[1] + h1[2] * h1[2] + h1[3] * h1[3];
                        u32x4 w; w.x = pg8::cvt_pk_bf16(h0[0], h0[1]); w.y = pg8::cvt_pk_bf16(h0[2], h0[3]); w.z = pg8::cvt_pk_bf16(h1[0], h1[1]); w.w = pg8::cvt_pk_bf16(h1[2], h1[3]);
                        *(u32x4*)(HBW + (size_t)r * 1024 + c) = w; } }
                if (!partial) { sq += __shfl_xor(sq, 16); sq += __shfl_xor(sq, 32); if (fq == 0) atomicAdd(ssq + r, sq); } }
    }
};

__device__ __forceinline__ void tr_tile(const float* src, int N, int k0, int n0, bf16_t* dst, int ldd, int kd0, const float* sc, LAS float* tile, int tid, int dn0 = -1) {
    if (dn0 < 0) dn0 = n0;
    { const int tr = tid >> 5, tc = tid & 31; float4 v[4];
#pragma unroll
      for (int i = 0; i < 4; ++i) v[i] = *(const float4*)(src + (size_t)(k0 + tr + i * 16) * N + n0 + tc * 4);
#pragma unroll
      for (int i = 0; i < 4; ++i) { const int k = tr + i * 16; const float s = sc ? sc[k] : 1.0f;
          tile[k * 129 + tc * 4 + 0] = v[i].x * s; tile[k * 129 + tc * 4 + 1] = v[i].y * s; tile[k * 129 + tc * 4 + 2] = v[i].z * s; tile[k * 129 + tc * 4 + 3] = v[i].w * s; } }
    __syncthreads();
#pragma unroll
    for (int h = 0; h < 2; ++h) { const int wn = (tid >> 3) + h * 64, wk = tid & 7; float e[8];
#pragma unroll
      for (int j = 0; j < 8; ++j) e[j] = tile[(wk * 8 + j) * 129 + wn];
      u32x4 w; w.x = pk2(e[0], e[1]); w.y = pk2(e[2], e[3]); w.z = pk2(e[4], e[5]); w.w = pk2(e[6], e[7]);
      *(u32x4*)(dst + (size_t)(dn0 + wn) * ldd + kd0 + wk * 8) = w; }
    __syncthreads();
}

__device__ __forceinline__ void ssm_prep(KP kp, int g, int half, LAS float* L, int tid) {
    LAS float* apr = L;
    LAS float* api = L + 17 * 64;
    LAS float* bbr = L + 2 * 17 * 64;
    LAS float* bbi = bbr + 1024;
    LAS float* crr = bbi + 1024;
    LAS float* cii = crr + 1024;
    LAS float* frs = cii + 1024;
    LAS float* fis = frs + 64;
    LAS float* ktau = fis + 64;
    unsigned char* ws = p.ws;
    if (tid < 64) {
        const float dt = expf(p.log_dt[g]); const float lr = p.lam_re[g * 64 + tid], li = p.lam_im[g * 64 + tid];
        const float mag = expf(lr * dt), ang = li * dt; const float ar = mag * cosf(ang), ai = mag * sinf(ang);
        const float den = lr * lr + li * li;
        frs[tid] = ((ar - 1.0f) * lr + ai * li) / den; fis[tid] = (ai * lr - (ar - 1.0f) * li) / den;
        float pr = 1.f, pi = 0.f;
        for (int t = 0; t <= 16; ++t) { apr[t * 64 + tid] = pr; api[t * 64 + tid] = pi; const float nr = pr * ar - pi * ai, ni = pr * ai + pi * ar; pr = nr; pi = ni; }
        if (half == 0) { ((float*)(ws + W_A16))[g * 64 + tid] = apr[16 * 64 + tid]; ((float*)(ws + W_A16))[2048 + g * 64 + tid] = api[16 * 64 + tid]; }
        const float m2 = ar * ar + ai * ai; const float ir = ar / m2, ii = -ai / m2; float qr = 1.f, qi = 0.f;
        for (int t = 0; t < 12; ++t) { const float nr = qr * ir - qi * ii, ni = qr * ii + qi * ir; qr = nr; qi = ni; }
        if (half == 0) { ((float*)(ws + W_AM12))[g * 64 + tid] = qr; ((float*)(ws + W_AM12))[2048 + g * 64 + tid] = qi; }
    }
    for (int i = tid; i < 1024; i += 512) { crr[i] = p.c_re[g * 1024 + i]; cii[i] = p.c_im[g * 1024 + i]; }
    __syncthreads();
    for (int i = tid; i < 1024; i += 512) { const int pp = i >> 4; const float br = p.b_re[g * 1024 + i], bi = p.b_im[g * 1024 + i];
        bbr[i] = frs[pp] * br - fis[pp] * bi; bbi[i] = frs[pp] * bi + fis[pp] * br; }
    __syncthreads();
    for (int i2 = tid; i2 < 2048; i2 += 512) { const int tau = i2 >> 7, co = half * 8 + ((i2 >> 4) & 7), ci = i2 & 15, i = tau * 256 + co * 16 + ci; float s = 0.f;
        for (int pp = 0; pp < 64; ++pp) { const float cr = crr[co * 64 + pp], cim = cii[co * 64 + pp], pr = apr[tau * 64 + pp], pi = api[tau * 64 + pp];
            const float xr = cr * pr - cim * pi, xi = cr * pi + cim * pr; s += xr * bbr[pp * 16 + ci] - xi * bbi[pp * 16 + ci]; }
        ktau[i] = s; }
    __syncthreads();
    bf16_t* WY = (bf16_t*)(ws + W_WY) + (size_t)g * 256 * KY;
    for (int i = tid; i < 128 * 48; i += 512) { const int n2 = i / 48, k0 = (i % 48) * 8, t = n2 >> 3, co = half * 8 + (n2 & 7), n = t * 16 + co; float e[8];
        if (k0 < 256) { const int s = k0 >> 4, ci0 = k0 & 15;
#pragma unroll
            for (int j = 0; j < 8; ++j) e[j] = (t >= s) ? ktau[(t - s) * 256 + co * 16 + ci0 + j] : 0.f; }
        else { const int kk = k0 - 256, ri = kk >> 6, p0 = kk & 63;
#pragma unroll
            for (int j = 0; j < 8; ++j) { const int pp = p0 + j; const float cr = crr[co * 64 + pp], cim = cii[co * 64 + pp], pr = apr[(t + 1) * 64 + pp], pi = api[(t + 1) * 64 + pp];
                e[j] = ri == 0 ? (cr * pr - cim * pi) : -(cr * pi + cim * pr); } }
        u32x4 w; w.x = pk2(e[0], e[1]); w.y = pk2(e[2], e[3]); w.z = pk2(e[4], e[5]); w.w = pk2(e[6], e[7]);
        *(u32x4*)(WY + (size_t)n * KY + k0) = w; }
    bf16_t* WE = (bf16_t*)(ws + W_WE) + (size_t)g * 256 * 256;
    for (int i = tid; i < 64 * 32; i += 512) { const int ri = half, pp = i >> 5, n = ri * 64 + pp, k0 = (i & 31) * 8, s = k0 >> 4, ci0 = k0 & 15; float e[8];
        const float pr = apr[(15 - s) * 64 + pp], pi = api[(15 - s) * 64 + pp];
#pragma unroll
        for (int j = 0; j < 8; ++j) { const float br = bbr[pp * 16 + ci0 + j], bi = bbi[pp * 16 + ci0 + j]; e[j] = ri == 0 ? (pr * br - pi * bi) : (pr * bi + pi * br); }
        u32x4 w; w.x = pk2(e[0], e[1]); w.y = pk2(e[2], e[3]); w.z = pk2(e[4], e[5]); w.w = pk2(e[6], e[7]);
        *(u32x4*)(WE + (size_t)n * 256 + k0) = w; }
    __syncthreads();
}

__device__ __forceinline__ void tr_do(KP kp, LAS float* tile, int tid, int ti) {
    unsigned char* ws = p.ws;
    if (ti < 192) { const int kt = ti / 12, nt = ti % 12; tr_tile(p.w_in, NPROJ, kt * 64, nt * 128, (bf16_t*)(ws + W_WIN), 1024, kt * 64, p.g_mix + kt * 64, tile, tid); }
    else if (ti < 224) { const int t2 = ti - 192, kt = t2 / 4, nt = t2 % 4; tr_tile(p.w_glu, 512, kt * 64, nt * 128, (bf16_t*)(ws + W_WGLU), 512, kt * 64, nullptr, tile, tid); }
    else if (ti < 352) { const int t2 = ti - 224, kt = t2 / 8, nt = t2 % 8; const int k0 = kt * 64;
        tr_tile(p.w_out, 1024, k0, nt * 128, (bf16_t*)(ws + W_WOUT), 1024, (k0 + 512) & 1023, k0 < 512 ? p.g_out_a + k0 : p.g_out_b + (k0 - 512), tile, tid); }
    else if (ti < 1056) { const int t2 = ti - 352, kt = t2 / 44, nt = t2 % 44; const int jn = nt * 128, hb = jn >= FF ? 1 : 0, jj = jn - hb * FF;
        tr_tile(p.w_ffn_in, FF2, kt * 64, jn, (bf16_t*)(ws + W_WUP), 1024, kt * 64, p.g_ffn + kt * 64, tile, tid, (jj >> 7) * 256 + hb * 128); }
    else { const int t2 = ti - 1056, kt = t2 / 8, nt = t2 % 8, n0 = nt * 128;
        tr_tile(p.w_ffn_out, 1024, kt * 64, n0, (bf16_t*)(ws + W_WDN), 64, 0, nullptr, tile, tid, ((n0 >> 8) * (FF / 64) + kt) * 256 + (n0 & 255)); }
}
__device__ __forceinline__ void tr_range(KP kp, LAS unsigned char* lds, int lo, int hi, int idx, int stride) {
    __syncthreads();
    for (int ti = lo + idx; ti < hi; ti += stride) tr_do(kp, (LAS float*)lds, threadIdx.x, ti);
}

__device__ __forceinline__ void phase0(KP kp, LAS unsigned char* lds) {
    const int tid = threadIdx.x, bid = blockIdx.x, G = gridDim.x, lane = tid & 63, wid = tid >> 6;
    unsigned char* ws = p.ws;
    { const int gt = bid * 512 + tid, GT = G * 512;
      float* z = (float*)(ws + W_SSQB); for (int i = gt; i < 3 * MTOK; i += GT) z[i] = 0.f;
      float* za = (float*)(ws + W_SSQA); for (int i = gt; i < MTOK; i += GT) za[i] = 0.f;
      bf16_t* wt = (bf16_t*)(ws + W_WTRIL); for (int i = gt; i < 65536; i += GT) { const int t = (i >> 7) & 127, s = i & 127; wt[i] = f2bf(s <= t ? p.w_s[i] : 0.f); }
      unsigned* ag = (unsigned*)(ws + W_AG);
      for (int i = gt; i < 32 * 128 * 96; i += GT) { const int gg = i / (128 * 96), rem = i % (128 * 96), b = rem / 96, k2 = rem % 96; ag[((size_t)(gg * MC16 + 1024 + b) * KY) / 2 + k2] = 0u; } }
    { bf16_t* XB = (bf16_t*)(ws + W_XB); float* R1 = (float*)(ws + W_R1);
      for (int row = (bid * 8 + wid) * 2; row < MTOK; row += G * 16) {
          float4 v[2][4]; float sq[2] = {0.f, 0.f};
#pragma unroll
          for (int rr = 0; rr < 2; ++rr) { const int r = row + rr; const float* src = r < MPR ? p.x_prompt + (size_t)r * 1024 : p.x_sample + (size_t)(r - MPR) * 1024;
#pragma unroll
              for (int i = 0; i < 2; ++i) { v[rr][2 * i] = *(const float4*)(src + i * 512 + lane * 8); v[rr][2 * i + 1] = *(const float4*)(src + i * 512 + lane * 8 + 4); } }
#pragma unroll
          for (int rr = 0; rr < 2; ++rr) {
#pragma unroll
              for (int i = 0; i < 4; ++i) sq[rr] += v[rr][i].x * v[rr][i].x + v[rr][i].y * v[rr][i].y + v[rr][i].z * v[rr][i].z + v[rr][i].w * v[rr][i].w;
#pragma unroll
              for (int o = 32; o >= 1; o >>= 1) sq[rr] += __shfl_xor(sq[rr], o);
              if (lane == 0) R1[row + rr] = rsqrtf(sq[rr] * (1.0f / 1024.0f) + EPS);
#pragma unroll
              for (int i = 0; i < 2; ++i) { u32x4 w; w.x = pk2(v[rr][2 * i].x, v[rr][2 * i].y); w.y = pk2(v[rr][2 * i].z, v[rr][2 * i].w); w.z = pk2(v[rr][2 * i + 1].x, v[rr][2 * i + 1].y); w.w = pk2(v[rr][2 * i + 1].z, v[rr][2 * i + 1].w);
                  *(u32x4*)(XB + (size_t)(row + rr) * 1024 + i * 512 + lane * 8) = w; } } } }
    LAS float* tile = (LAS float*)lds;
    for (int ti = bid; ti < 192; ti += G) tr_do(kp, tile, tid, ti);
}

__device__ __forceinline__ void sgu_phase(KP kp, LAS unsigned char* lds, int first_item_offset) {
    const int tid = threadIdx.x, G = gridDim.x, lane = tid & 63, wid = tid >> 6, fr = lane & 15, fq = lane >> 4;
    unsigned char* ws = p.ws;
    const bf16_t* U = (const bf16_t*)(ws + W_U); const bf16_t* V = (const bf16_t*)(ws + W_V); const bf16_t* WT = (const bf16_t*)(ws + W_WTRIL);
    bf16_t* AOUT = (bf16_t*)(ws + W_AOUT); float* SSQA = (float*)(ws + W_SSQA);
    LAS bf16_t* vnT = (LAS bf16_t*)lds;
    const bool free_wg = (G == 256) && ((int)blockIdx.x >= first_item_offset);
    const int it0 = (G == 256) ? (free_wg ? (int)blockIdx.x - first_item_offset : 384 + (int)blockIdx.x) : (int)blockIdx.x;
    const int itstep = (G == 256) ? (free_wg ? G - first_item_offset : 1024) : G, itend = (G == 256 && free_wg) ? 384 : 516;
    for (int item = it0; item < itend; item += itstep) {
        if (item < 512) {
            const int t0 = (item >> 2) * 128, tb = wid, trow = tb * 16 + fr;
            float sq = 0.f;
            { const int h = item & 3;
                const int nk = (tb >> 1) + 1; bf16x8 wfr[4];
#pragma unroll
                for (int ks = 0; ks < 4; ++ks) if (ks < nk) wfr[ks] = *(const bf16x8*)(WT + (size_t)(h * 128 + trow) * 128 + ks * 32 + fq * 8);
                { const int row = tid >> 2, q = tid & 3; const bf16_t* vp = V + (size_t)(t0 + row) * 512 + h * 128 + q * 32;
                  u32x4 w[4]; float s2 = 0.f;
#pragma unroll
                  for (int i = 0; i < 4; ++i) { w[i] = *(const u32x4*)(vp + i * 8);
                      const float a0 = bflo(w[i].x), a1 = bfhi(w[i].x), a2 = bflo(w[i].y), a3 = bfhi(w[i].y), a4 = bflo(w[i].z), a5 = bfhi(w[i].z), a6 = bflo(w[i].w), a7 = bfhi(w[i].w);
                      s2 += a0 * a0 + a1 * a1 + a2 * a2 + a3 * a3 + a4 * a4 + a5 * a5 + a6 * a6 + a7 * a7; }
                  s2 += __shfl_xor(s2, 1); s2 += __shfl_xor(s2, 2);
                  const float rs = rsqrtf(s2 * (1.0f / 128.0f) + EPS); const float* gv = p.g_v + h * 128 + q * 32;
#pragma unroll
                  for (int i = 0; i < 4; ++i) { const unsigned ww[4] = {w[i].x, w[i].y, w[i].z, w[i].w};
#pragma unroll
                      for (int j = 0; j < 4; ++j) { const int d = q * 32 + i * 8 + j * 2;
                          vnT[d * 136 + row] = f2bf(bflo(ww[j]) * rs * gv[i * 8 + j * 2]); vnT[(d + 1) * 136 + row] = f2bf(bfhi(ww[j]) * rs * gv[i * 8 + j * 2 + 1]); } } }
                __syncthreads();
                f32x4 acc[8];
#pragma unroll
                for (int db = 0; db < 8; ++db) acc[db] = (f32x4){0.f, 0.f, 0.f, 0.f};
#pragma unroll
                for (int ks = 0; ks < 4; ++ks) if (ks < nk) {
                    const bf16x8 wf = wfr[ks];
#pragma unroll
                    for (int db = 0; db < 8; ++db) { const bf16x8 xf = *(const LAS bf16x8*)(vnT + (db * 16 + fr) * 136 + ks * 32 + fq * 8);
                        acc[db] = __builtin_amdgcn_mfma_f32_16x16x32_bf16(xf, wf, acc[db], 0, 0, 0); }
                }
                const float bs = p.b_s[h * 128 + trow];
#pragma unroll
                for (int db = 0; db < 8; ++db) { const u32x2 uw = *(const u32x2*)(U + (size_t)(t0 + trow) * 512 + h * 128 + db * 16 + 4 * fq);
                    const float a0 = bflo(uw.x) * (acc[db][0] + bs), a1 = bfhi(uw.x) * (acc[db][1] + bs), a2 = bflo(uw.y) * (acc[db][2] + bs), a3 = bfhi(uw.y) * (acc[db][3] + bs);
                    sq += a0 * a0 + a1 * a1 + a2 * a2 + a3 * a3; u32x2 w; w.x = pk2(a0, a1); w.y = pk2(a2, a3);
                    *(u32x2*)(AOUT + (size_t)(t0 + trow) * 512 + h * 128 + db * 16 + 4 * fq) = w;
#ifdef SGU_DIRECT
                    *(f32x4*)((float*)(ws + W_HB) + (size_t)(t0 + trow) * 512 + h * 128 + db * 16 + 4 * fq) = (f32x4){a0, a1, a2, a3};
#endif
 }
                __syncthreads();
            }
            sq += __shfl_xor(sq, 16); sq += __shfl_xor(sq, 32);
            if (fq == 0) atomicAdd(SSQA + t0 + trow, sq);
        } else {
            const int sc = item - 512, sqn = tid >> 4, h = (tid >> 2) & 3, dq = tid & 3, b = sc * 32 + sqn, row0 = MPR + b * 4;
            float rs[4];
#pragma unroll
            for (int j = 0; j < 4; ++j) { const bf16_t* vp = V + (size_t)(row0 + j) * 512 + h * 128 + dq * 32; float s2 = 0.f;
#pragma unroll
                for (int i = 0; i < 4; ++i) { const u32x4 w = *(const u32x4*)(vp + i * 8); const unsigned ww[4] = {w.x, w.y, w.z, w.w};
#pragma unroll
                    for (int k = 0; k < 4; ++k) { const float a = bflo(ww[k]), c = bfhi(ww[k]); s2 += a * a + c * c; } }
                s2 += __shfl_xor(s2, 1); s2 += __shfl_xor(s2, 2); rs[j] = rsqrtf(s2 * (1.0f / 128.0f) + EPS); }
            float wsj[4][4], bsj[4];
#pragma unroll
            for (int j = 0; j < 4; ++j) { bsj[j] = p.b_s[h * 128 + j];
#pragma unroll
                for (int k = 0; k < 4; ++k) wsj[j][k] = (k <= j) ? p.w_s[(size_t)(h * 128 + j) * 128 + k] : 0.f; }
            float ssa[4] = {0.f, 0.f, 0.f, 0.f};
            { const int sweep = 0;
                for (int i = 0; i < 4; ++i) { const int d0 = dq * 32 + i * 8; float vn[4][8];
#pragma unroll
                    for (int j = 0; j < 4; ++j) { const u32x4 w = *(const u32x4*)(V + (size_t)(row0 + j) * 512 + h * 128 + d0); const unsigned ww[4] = {w.x, w.y, w.z, w.w};
#pragma unroll
                        for (int k = 0; k < 4; ++k) { vn[j][2 * k] = bflo(ww[k]) * rs[j] * p.g_v[h * 128 + d0 + 2 * k]; vn[j][2 * k + 1] = bfhi(ww[k]) * rs[j] * p.g_v[h * 128 + d0 + 2 * k + 1]; }
                        if (sweep == 0) { float* o = p.out + O_VS + ((size_t)((b * 4 + j) * 4 + h)) * 128 + d0;
                            *(f32x4*)o = (f32x4){vn[j][0], vn[j][1], vn[j][2], vn[j][3]}; *(f32x4*)(o + 4) = (f32x4){vn[j][4], vn[j][5], vn[j][6], vn[j][7]}; } }
#pragma unroll
                    for (int j = 0; j < 4; ++j) { const u32x4 uw = *(const u32x4*)(U + (size_t)(row0 + j) * 512 + h * 128 + d0); const unsigned uu[4] = {uw.x, uw.y, uw.z, uw.w}; float a[8];
#pragma unroll
                        for (int e = 0; e < 8; ++e) { float s = bsj[j];
#pragma unroll
                            for (int k = 0; k < 4; ++k) s += wsj[j][k] * vn[k][e];
                            const float uv = (e & 1) ? bfhi(uu[e >> 1]) : bflo(uu[e >> 1]); a[e] = uv * s; }
#pragma unroll
                        for (int e = 0; e < 8; ++e) ssa[j] += a[e] * a[e];
                        { u32x4 w; w.x = pk2(a[0], a[1]); w.y = pk2(a[2], a[3]); w.z = pk2(a[4], a[5]); w.w = pk2(a[6], a[7]);
                            *(u32x4*)(AOUT + (size_t)(row0 + j) * 512 + h * 128 + d0) = w; } } }
#pragma unroll
                for (int j = 0; j < 4; ++j) { float s = ssa[j]; s += __shfl_xor(s, 1); s += __shfl_xor(s, 2); s += __shfl_xor(s, 4); s += __shfl_xor(s, 8); if ((tid & 15) == 0) SSQA[row0 + j] = s; }
            }
        }
    }
}

__device__ __forceinline__ void scan_phase(KP kp) {
    unsigned char* ws = p.ws; const float* EB = (const float*)(ws + W_EB); bf16_t* AG = (bf16_t*)(ws + W_AG);
    const float* A16 = (const float*)(ws + W_A16); const float* AM12 = (const float*)(ws + W_AM12);
    const int GT = gridDim.x * 512;
    for (int id = blockIdx.x * 512 + threadIdx.x; id < 16384 * 8; id += GT) {
        const int seg = id & 7, sid = id >> 3, b = sid >> 11, gp = sid & 2047, gg = gp >> 6, pp = gp & 63; const float ar = A16[gp], ai = A16[2048 + gp];
        const size_t rbase = (size_t)gg * MC16 + b * 128 + seg * 16;
        float er[16], ei[16];
#pragma unroll
        for (int k = 0; k < 16; ++k) { er[k] = EB[(rbase + k) * 128 + pp]; ei[k] = EB[(rbase + k) * 128 + 64 + pp]; }
        float hr = 0.f, hi = 0.f;
#pragma unroll
        for (int k = 0; k < 16; ++k) { const float nr = ar * hr - ai * hi + er[k], ni = ar * hi + ai * hr + ei[k]; hr = nr; hi = ni; }
        float mr = ar, mi = ai;
#pragma unroll
        for (int q = 0; q < 4; ++q) { const float nr = mr * mr - mi * mi, ni = 2.f * mr * mi; mr = nr; mi = ni; }
#pragma unroll
        for (int d = 1; d < 8; d <<= 1) {
            const float hpr = __shfl_up(hr, d, 8), hpi = __shfl_up(hi, d, 8), mpr = __shfl_up(mr, d, 8), mpi = __shfl_up(mi, d, 8);
            if (seg >= d) { const float nhr = hr + mr * hpr - mi * hpi, nhi = hi + mr * hpi + mi * hpr, nmr = mr * mpr - mi * mpi, nmi = mr * mpi + mi * mpr; hr = nhr; hi = nhi; mr = nmr; mi = nmi; } }
        float cr = __shfl_up(hr, 1, 8), ci = __shfl_up(hi, 1, 8); if (seg == 0) { cr = 0.f; ci = 0.f; }
#pragma unroll
        for (int k = 0; k < 16; ++k) { bf16_t* hp = AG + (rbase + k) * KY + 256 + pp; hp[0] = f2bf(cr); hp[64] = f2bf(ci);
            const float nr = ar * cr - ai * ci + er[k], ni = ar * ci + ai * cr + ei[k]; cr = nr; ci = ni; }
        if (seg == 7) { p.out[O_SRP + sid] = cr; p.out[O_SIP + sid] = ci; }
    }
    for (int id = 16384 + blockIdx.x * 512 + threadIdx.x; id < (8 + 128) * 2048; id += GT) {
        if (false) {
        } else { const int id2 = id - 16384, b = id2 >> 11, gp = id2 & 2047, gg = gp >> 6, pp = gp & 63;
            const float sr = p.st_re[id2], si = p.st_im[id2], qr = AM12[gp], qi = AM12[2048 + gp];
            const float hr = sr * qr - si * qi, hi = sr * qi + si * qr; const size_t row = (size_t)gg * MC16 + 1024 + b;
            bf16_t* hp = AG + row * KY + 256 + pp; hp[0] = f2bf(hr); hp[64] = f2bf(hi);
            const float ar = A16[gp], ai = A16[2048 + gp];
            p.out[O_SRS + id2] = ar * hr - ai * hi + EB[row * 128 + pp]; p.out[O_SIS + id2] = ar * hi + ai * hr + EB[row * 128 + 64 + pp]; }
    }
    { bf16_t* MIX = (bf16_t*)(ws + W_MIX); const bf16_t* AOUT = (const bf16_t*)(ws + W_AOUT); const float* SSQA = (const float*)(ws + W_SSQA);
      for (int i = blockIdx.x * 512 + threadIdx.x; i < MTOK * 64; i += GT) { const int r = i >> 6, c = (i & 63) * 8; const float ra = rsqrtf(SSQA[r] * (1.0f / 512.0f) + EPS);
          u32x4* mp = (u32x4*)(MIX + (size_t)r * 1024 + 512 + c); const u32x4 o = *(const u32x4*)(AOUT + (size_t)r * 512 + c); u32x4 w;
          w.x = pk2(bflo(o.x) * ra, bfhi(o.x) * ra); w.y = pk2(bflo(o.y) * ra, bfhi(o.y) * ra); w.z = pk2(bflo(o.z) * ra, bfhi(o.z) * ra); w.w = pk2(bflo(o.w) * ra, bfhi(o.w) * ra); *mp = w; } }
}

__device__ __forceinline__ void ld8bf(const bf16_t* q, float (&o)[8]) { const u32x4 w = *(const u32x4*)q; o[0] = bflo(w.x); o[1] = bfhi(w.x); o[2] = bflo(w.y); o[3] = bfhi(w.y); o[4] = bflo(w.z); o[5] = bfhi(w.z); o[6] = bflo(w.w); o[7] = bfhi(w.w); }
__device__ __forceinline__ void ld8f(const float* q, float (&o)[8]) { const f32x4 a = *(const f32x4*)q, b = *(const f32x4*)(q + 4); o[0] = a[0]; o[1] = a[1]; o[2] = a[2]; o[3] = a[3]; o[4] = b[0]; o[5] = b[1]; o[6] = b[2]; o[7] = b[3]; }
__device__ __forceinline__ void act_phase(KP kp) {
    unsigned char* ws = p.ws; bf16_t* ACT = (bf16_t*)(ws + W_ACT); const bf16_t* HALO = (const bf16_t*)(ws + W_HALO); const bf16_t* HEAD = (const bf16_t*)(ws + W_HEAD); const bf16_t* UPS = (const bf16_t*)(ws + W_UPS);
    const int GT = gridDim.x * 512, gt = blockIdx.x * 512 + threadIdx.x;
    const float* cw = p.conv_w; const float* cb = p.conv_b;
    for (int e = gt; e < (512 + 512) * 352; e += GT) {
        const int rowi = e / 352, col = (e % 352) * 8;
        float ga[8], va[8], t[8], w[8]; int orow;
        ld8f(cb + col, ga); ld8f(cb + FF + col, va);
        if (rowi < 512) { const int k = rowi >> 1, rr = rowi & 1; const bool hist = ((k * 64) & 2047) != 0; orow = k * 64 + rr;
#pragma unroll
            for (int q = 0; q < 3; ++q) { const int idx = rr + q - 2; const bf16_t* src = nullptr;
                if (idx >= 0) src = HEAD + (size_t)(k * 2 + idx) * FF2 + col; else if (hist) src = HALO + (size_t)((k - 1) * 2 + idx + 2) * FF2 + col;
                if (src) { ld8bf(src, t); ld8f(cw + q * FF2 + col, w);
#pragma unroll
                    for (int i = 0; i < 8; ++i) ga[i] += w[i] * t[i];
                    ld8bf(src + FF, t); ld8f(cw + q * FF2 + FF + col, w);
#pragma unroll
                    for (int i = 0; i < 8; ++i) va[i] += w[i] * t[i]; } } }
        else { const int rs = rowi - 512, b = rs >> 2, j = rs & 3; orow = MPR + rs;
#pragma unroll
            for (int q = 0; q < 3; ++q) { const int idx = j + q - 2;
                if (idx >= 0) { const bf16_t* src = UPS + (size_t)(b * 4 + idx) * FF2 + col; ld8bf(src, t); ld8f(cw + q * FF2 + col, w);
#pragma unroll
                    for (int i = 0; i < 8; ++i) ga[i] += w[i] * t[i];
                    ld8bf(src + FF, t); ld8f(cw + q * FF2 + FF + col, w);
#pragma unroll
                    for (int i = 0; i < 8; ++i) va[i] += w[i] * t[i]; }
                else { const float* src = p.st_conv + (size_t)(b * 2 + idx + 2) * FF2 + col; ld8f(src, t); ld8f(cw + q * FF2 + col, w);
#pragma unroll
                    for (int i = 0; i < 8; ++i) ga[i] += w[i] * t[i];
                    ld8f(src + FF, t); ld8f(cw + q * FF2 + FF + col, w);
#pragma unroll
                    for (int i = 0; i < 8; ++i) va[i] += w[i] * t[i]; } } }
        u32x4 o; o.x = pk2(gelu_t(ga[0]) * va[0], gelu_t(ga[1]) * va[1]); o.y = pk2(gelu_t(ga[2]) * va[2], gelu_t(ga[3]) * va[3]);
        o.z = pk2(gelu_t(ga[4]) * va[4], gelu_t(ga[5]) * va[5]); o.w = pk2(gelu_t(ga[6]) * va[6], gelu_t(ga[7]) * va[7]);
        *(u32x4*)(ACT + act_off(orow, col)) = o;
    }
}

__device__ __forceinline__ void final_phase(KP kp) {
    const float* ssq = (const float*)(p.ws + W_SSQF); const int GT = gridDim.x * 512;
    for (int i = blockIdx.x * 512 + threadIdx.x; i < MPR * 128; i += GT) { const int r = i >> 7, c = (i & 127) * 8;
        const float s = rsqrtf(ssq[r] * (1.0f / 1024.0f) + EPS); float* hp = p.out + (size_t)r * 1024 + c; const f32x4 g0 = *(const f32x4*)(p.g_final + c), g1 = *(const f32x4*)(p.g_final + c + 4);
        const u32x4 hw = *(const u32x4*)((const bf16_t*)(p.ws + W_HB) + (size_t)r * 1024 + c);
        *(f32x4*)hp = (f32x4){bflo(hw.x), bfhi(hw.x), bflo(hw.y), bfhi(hw.y)} * s * g0; *(f32x4*)(hp + 4) = (f32x4){bflo(hw.z), bfhi(hw.z), bflo(hw.w), bfhi(hw.w)} * s * g1; }
    const int lane = threadIdx.x & 63, wv = blockIdx.x * 8 + (threadIdx.x >> 6);
    const float* PART = (const float*)(p.ws + W_PART);
    for (int r = MPR + wv; r < MTOK; r += gridDim.x * 8) { f32x4* hp = (f32x4*)(p.out + (size_t)r * 1024); f32x4 v[4]; float sq = 0.f;
#pragma unroll
        for (int i = 0; i < 4; ++i) { v[i] = (f32x4){0.f, 0.f, 0.f, 0.f};
            for (int kc = 0; kc < 11; ++kc) v[i] += ((const f32x4*)(PART + ((size_t)kc * 512 + (r - MPR)) * 1024))[lane + i * 64];
            sq += v[i][0] * v[i][0] + v[i][1] * v[i][1] + v[i][2] * v[i][2] + v[i][3] * v[i][3]; }
#pragma unroll
        for (int o = 32; o >= 1; o >>= 1) sq += __shfl_xor(sq, o);
        const float s = rsqrtf(sq * (1.0f / 1024.0f) + EPS);
#pragma unroll
        for (int i = 0; i < 4; ++i) hp[lane + i * 64] = v[i] * s * ((const f32x4*)p.g_final)[lane + i * 64]; }
}

__global__ void __launch_bounds__(512, 2) fwd_kernel(Params p_unused) {
    extern __shared__ __attribute__((aligned(16))) unsigned char shm[];
    KP kp = (KP)__builtin_amdgcn_kernarg_segment_ptr();
    LAS unsigned char* lds = (LAS unsigned char*)shm;
    cg::grid_group grid = cg::this_grid();
    unsigned char* ws = p.ws; const int G = gridDim.x, bid = blockIdx.x;
    const int lo = p.ph_lo, hi = p.ph_hi;
    if (threadIdx.x < 2) ((volatile LAS unsigned*)(lds + 131072))[threadIdx.x] = 0u;
    __syncthreads();
    if (threadIdx.x == 0) (void)xb_add(&((unsigned*)(p.ws + W_BAR))[XB_XCNT(xb_xcc_id())], 1u);
    if (lo < 0) grid.sync();
    const int cid = bid;
#ifndef PHMASK
#define PHMASK 0x7ff
#endif
#define IN(k) (((PHMASK >> (k)) & 1) && lo <= (k) && (k) < hi)
#define GSYNC() xcd_barrier((unsigned*)(p.ws + W_BAR), (volatile LAS unsigned*)(lds + 131072))
#define SYNC(k) do { if (IN(k) && IN((k) + 1)) GSYNC(); } while (0)
    if (IN(0)) { phase0(kp, lds); } SYNC(0);
    if (IN(1)) { pg8::Gemm g = pg8::gemm_rm((const bf16_t*)(ws + W_XB), (const bf16_t*)(ws + W_WIN), 1024, 1024); pg8::StaticOrder S; S.init(MTOK, NPROJ, 1024, G, cid);
        EpiProj E{(const float*)(ws + W_R1), (bf16_t*)(ws + W_U), (bf16_t*)(ws + W_V), (bf16_t*)(ws + W_AG)};
        pg8::gemm_phase(lds, g, S, E, pg8::NoMid{});
        if (cid >= G - 64) { __syncthreads(); ssm_prep(kp, (cid - (G - 64)) >> 1, (cid - (G - 64)) & 1, (LAS float*)lds, threadIdx.x); }
        else if (cid >= 140) tr_range(kp, lds, 1056, 1408, cid - 140, G - 64 - 140); } SYNC(1);
    if (IN(2)) { { pg8::Gemm g = pg8::gemm_rm((const bf16_t*)(ws + W_AG), (const bf16_t*)(ws + W_WE), KY, 256); pg8::BatchedOrder S{160, 5, G, bid, 4}; EpiE E{(float*)(ws + W_EB)};
          pg8::gemm_phase(lds, g, S, E, pg8::NoMid{}); }
        __syncthreads();
        sgu_phase(kp, lds, 160); } SYNC(2);
    if (IN(3)) { scan_phase(kp); tr_range(kp, lds, 192, 352, bid, G); } SYNC(3);
    if (IN(4)) { pg8::Gemm g = pg8::gemm_rm((const bf16_t*)(ws + W_AG), (const bf16_t*)(ws + W_WY), KY, KY); pg8::BatchedOrder S{160, 5, G, bid, 6};
        EpiY E{(const bf16_t*)(ws + W_AG), p.d_skip, (bf16_t*)(ws + W_GB)};
        pg8::gemm_phase(lds, g, S, E, pg8::NoMid{});
        if (bid >= 160) tr_range(kp, lds, 352, 1056, bid - 160, G - 160); } SYNC(4);
    if (IN(5)) { pg8::Gemm g = pg8::gemm_rm((const bf16_t*)(ws + W_GB), (const bf16_t*)(ws + W_WGLU), 512, 512); pg8::StaticOrder S; S.init(MTOK, 512, 512, G, cid);
        EpiGlu E{(const bf16_t*)(ws + W_GB), p.b_glu, (bf16_t*)(ws + W_MIX), (float*)(ws + W_SSQB)};
        pg8::gemm_phase(lds, g, S, E, pg8::NoMid{}); } SYNC(5);
    if (IN(6)) { pg8::Gemm g = pg8::gemm_rm((const bf16_t*)(ws + W_MIX), (const bf16_t*)(ws + W_WOUT), 1024, 1024); pg8::SplitOrder S; S.init(MPR, 1024, 1024, G, cid);
        EpiOut E{p.x_prompt, p.x_sample, p.out, (bf16_t*)(ws + W_HB), (float*)(ws + W_SSQH), (const float*)(ws + W_SSQB), (float*)(ws + W_PART), (const bf16_t*)(ws + W_XB)}; MidOut MD{(const float*)(ws + W_SSQB)};
        pg8::gemm_phase(lds, g, S, E, MD);
        GSYNC();
        {
            const int lane = threadIdx.x & 63; const float* PART = (const float*)(ws + W_PART); bf16_t* HB = (bf16_t*)(ws + W_HB); float* SSQH = (float*)(ws + W_SSQH);
            for (int rs = bid * 8 + (threadIdx.x >> 6); rs < 512; rs += G * 8) { float sq = 0.f;
#pragma unroll
                for (int i = 0; i < 4; ++i) { f32x4 v = ((const f32x4*)(p.x_sample + (size_t)rs * 1024))[lane + i * 64];
#pragma unroll
                    for (int kc = 0; kc < 4; ++kc) v += ((const f32x4*)(PART + ((size_t)kc * 512 + rs) * 1024))[lane + i * 64];
                    sq += v[0] * v[0] + v[1] * v[1] + v[2] * v[2] + v[3] * v[3];
                    u32x2 w; w.x = pk2(v[0], v[1]); w.y = pk2(v[2], v[3]); ((u32x2*)(HB + (size_t)(MPR + rs) * 1024))[lane + i * 64] = w; }
#pragma unroll
                for (int o = 32; o >= 1; o >>= 1) sq += __shfl_xor(sq, o);
                if (lane == 0) SSQH[MPR + rs] = sq; } } } SYNC(6);
    if (IN(7)) { pg8::Gemm g = pg8::gemm_rm((const bf16_t*)(ws + W_HB), (const bf16_t*)(ws + W_WUP), 1024, 1024); pg8::StaticOrder S; S.init(MTOK, FF2, 1024, G, cid);
        EpiUp E{(const float*)(ws + W_SSQH), (bf16_t*)(ws + W_ACT), (bf16_t*)(ws + W_HALO), (bf16_t*)(ws + W_HEAD), (bf16_t*)(ws + W_UPS), p.out, p.conv_w, p.conv_b};
        pg8::gemm_phase(lds, g, S, E, pg8::NoMid{}); } SYNC(7);
    if (IN(8)) { act_phase(kp); } SYNC(8);
    if (IN(9)) { pg8::Gemm g{(const bf16_t*)(ws + W_ACT), (const bf16_t*)(ws + W_WDN), 64, 64, 32768, 32768, (size_t)32768 * (FF / 64), (size_t)32768 * (FF / 64)}; pg8::SplitOrder S; S.init(MPR, 1024, FF, G, cid);
        EpiDown E{p.out, (float*)(ws + W_SSQF), (const bf16_t*)(ws + W_HB), (float*)(ws + W_PART), (bf16_t*)(ws + W_HB)};
        pg8::gemm_phase(lds, g, S, E, pg8::NoMid{}); } SYNC(9);
    if (IN(10)) { final_phase(kp); }
#ifdef DUMP_OFF
    { GSYNC();
      const bf16_t* src = (const bf16_t*)(ws + (DUMP_OFF)); for (size_t i = (size_t)bid * 512 + threadIdx.x; i < (size_t)(DUMP_N); i += (size_t)G * 512) p.out[i] = __uint_as_float((unsigned)src[i] << 16); }
#endif
#ifdef DUMPF_OFF
    { GSYNC();
      const float* src = (const float*)(ws + (DUMPF_OFF)); for (size_t i = (size_t)bid * 512 + threadIdx.x; i < (size_t)(DUMPF_N); i += (size_t)G * 512) p.out[i] = src[i]; }
#endif
#undef IN
#undef SYNC
#undef p
}

extern "C" void kernel_launch(void* const* d_in, const int* in_sizes, int n_in, void* d_out, int out_size, void* d_ws, size_t ws_size, hipStream_t stream) {
    static int grid = 0;
    if (grid == 0) {
        if (n_in != 29 || ws_size < W_END) { fprintf(stderr, "kernel_launch: unexpected n_in %d / ws_size %zu (need %zu)\n", n_in, ws_size, (size_t)W_END); grid = -1; return; }
        int dev = 0, cus = 0, per_cu = 0;
        hipGetDevice(&dev); hipDeviceGetAttribute(&cus, hipDeviceAttributeMultiprocessorCount, dev);
        if (hipFuncSetAttribute((const void*)fwd_kernel, hipFuncAttributeMaxDynamicSharedMemorySize, LDS_BYTES) != hipSuccess) { fprintf(stderr, "kernel_launch: hipFuncSetAttribute failed\n"); (void)hipGetLastError(); }
        if (hipOccupancyMaxActiveBlocksPerMultiprocessor(&per_cu, (const void*)fwd_kernel, 512, LDS_BYTES) != hipSuccess || per_cu < 1) { per_cu = 1; (void)hipGetLastError(); }
        if (per_cu > 1) per_cu = 1;
        grid = cus * per_cu;
        if (grid > 256) grid = 256;
    }
    if (grid < 0) return;
    Params p{};
    const float** pp = (const float**)&p;
    for (int i = 0; i < 29; ++i) pp[i] = (const float*)d_in[i];
    p.out = (float*)d_out; p.ws = (unsigned char*)d_ws; p.ph_lo = 0; p.ph_hi = PH_HI;
    (void)hipMemsetAsync((unsigned char*)d_ws + W_BAR, 0, XCD_BAR_WORDS * 4, stream);
    void* args[] = {&p};
    hipError_t e = hipLaunchCooperativeKernel((const void*)fwd_kernel, dim3(grid), dim3(512), args, LDS_BYTES, stream);
    if (e != hipSuccess) fprintf(stderr, "cooperative launch failed: %s (grid %d)\n", hipGetErrorString(e), grid);
}
```

```cpp
#include <hip/hip_runtime.h>
#include <hip/hip_cooperative_groups.h>
#include <cstdio>
#define PH_HI 11
namespace cg = cooperative_groups;

#define LAS __attribute__((address_space(3)))
typedef unsigned short bf16_t;
typedef short bf16x8 __attribute__((ext_vector_type(8)));
typedef float f32x4 __attribute__((ext_vector_type(4)));
typedef unsigned u32x4 __attribute__((ext_vector_type(4)));
typedef unsigned u32x2 __attribute__((ext_vector_type(2)));

constexpr int MTOK = 16896, MPR = 16384, DM = 1024, NPROJ = 1536, FF = 2816, FF2 = 5632;
constexpr int MC16 = 1280, KY = 384;
constexpr float EPS = 1e-6f;
constexpr size_t O_Y = 0, O_VS = 17301504, O_SRP = 17563648, O_SIP = 17580032, O_CP = 17596416, O_SRS = 17686528, O_SIS = 17948672, O_CS = 18210816;
constexpr size_t W_WUP = 0, W_WDN = 11534336, W_HB = 17301504, W_HALO = 51904512, W_UPS = 57851904, W_SSQB = 63619072, W_SSQH = 63686656,
                 W_SSQF = 63754240, W_R1 = 63821824, W_A16 = 63889408, W_AM12 = 63905792, W_SSQA = 63922176, W_BAR = 63989760, W_UP = 64006144;
constexpr size_t W_WIN = W_UP + 0, W_WGLU = W_UP + 3145728, W_WOUT = W_UP + 3670016, W_WTRIL = W_UP + 5767168, W_WY = W_UP + 5898240,
                 W_WE = W_UP + 12189696, W_XB = W_UP + 16384000, W_GB = W_UP + 50987008  , W_U = W_UP + 50987008, W_V = W_UP + 68288512,
                 W_AG = W_UP + 85590016, W_EB = W_UP + 117047296, W_MIX = W_UP + 138018816, W_AOUT = W_UP + 172621824;
constexpr size_t W_ACT = W_UP, W_HEAD = W_UP + 100663296, W_PART = W_UP + 110100480;
constexpr size_t W_END = W_UP + (size_t)MTOK * FF2 * 2;
constexpr int LDS_BYTES = 131072 + 16;

struct Params {
    const float *x_prompt, *x_sample, *st_re, *st_im, *st_conv, *g_mix, *w_in, *g_v, *w_s, *b_s, *lam_re, *lam_im, *log_dt, *b_re, *b_im, *c_re, *c_im,
        *d_skip, *w_glu, *b_glu, *g_out_a, *g_out_b, *w_out, *g_ffn, *w_ffn_in, *conv_w, *conv_b, *w_ffn_out, *g_final;
    float* out; unsigned char* ws; int ph_lo, ph_hi;
};
typedef const __attribute__((address_space(4))) Params* KP;
#define p (*kp)

__device__ __forceinline__ unsigned short f2bf(float f) { unsigned u = __float_as_uint(f); u += 0x7FFFu + ((u >> 16) & 1u); return (unsigned short)(u >> 16); }
__device__ __forceinline__ float bflo(unsigned w) { return __uint_as_float(w << 16); }
__device__ __forceinline__ float bfhi(unsigned w) { return __uint_as_float(w & 0xffff0000u); }
__device__ __forceinline__ unsigned pk2(float lo, float hi) { return (unsigned)f2bf(lo) | ((unsigned)f2bf(hi) << 16); }
__device__ __forceinline__ float gelu_t(float x) { const float z = -2.3022082f * (x + 0.044715f * x * x * x); return x * __builtin_amdgcn_rcpf(1.0f + __builtin_amdgcn_exp2f(z)); }
__device__ __forceinline__ float sigm(float x) { return __builtin_amdgcn_rcpf(1.0f + __builtin_amdgcn_exp2f(-1.44269504f * x)); }
template <int CTRL> __device__ __forceinline__ float dpps(float old, float v) { return __int_as_float(__builtin_amdgcn_update_dpp(__float_as_int(old), __float_as_int(v), CTRL, 0xf, 0xf, false)); }
template <int CTRL> __device__ __forceinline__ float dppf(float v) { return __int_as_float(__builtin_amdgcn_update_dpp(0, __float_as_int(v), CTRL, 0xf, 0xf, false)); }


#define XB_TMO      128
#define XB_XCNT(j)  (256  + 64 * (j))
#define XB_XSUB(j)  (1280 + 64 * (j))
#define XB_XGEN(j)  (2304 + 64 * (j))
#define XB_TOP      3328
#define XB_TOPGEN   3392
#define XCD_BAR_WORDS 3456
#define XB_SPIN_CAP (1u << 18)
__device__ __forceinline__ unsigned xb_ld(unsigned* q)              { return __hip_atomic_load(q, __ATOMIC_RELAXED, __HIP_MEMORY_SCOPE_AGENT); }
__device__ __forceinline__ unsigned xb_add(unsigned* q, unsigned v) { return __hip_atomic_fetch_add(q, v, __ATOMIC_RELAXED, __HIP_MEMORY_SCOPE_AGENT); }
__device__ __forceinline__ unsigned xb_xcc_id() { return (unsigned)__builtin_amdgcn_s_getreg((3 << 11) | 20) & 0xFu; }
#define XB_SPIN(cond, bar) do { unsigned _sp = 0; while (cond) { __builtin_amdgcn_s_sleep(1); \
    if ((++_sp & 255u) == 0u) { if (xb_ld(&(bar)[XB_TMO])) break; if (_sp > XB_SPIN_CAP) { atomicAdd(&(bar)[XB_TMO], 1u); break; } } } } while (0)
__device__ __forceinline__ void xcd_barrier_complete(unsigned* bar, unsigned x, unsigned& nloc, unsigned& nx) {
    const unsigned G = gridDim.x;
    unsigned sum, cnt, mine, sp = 0u;
    for (;;) {
        sum = 0u; cnt = 0u; mine = 0u;
#pragma unroll
        for (unsigned j = 0; j < 16; ++j) { const unsigned c = xb_ld(&bar[XB_XCNT(j)]); sum += c; cnt += (c > 0u) ? 1u : 0u; mine = (j == x) ? c : mine; }
        if (sum == G) break;
        __builtin_amdgcn_s_sleep(1);
        if ((++sp & 255u) == 0u) { if (xb_ld(&bar[XB_TMO])) break; if (sp > XB_SPIN_CAP) { atomicAdd(&bar[XB_TMO], 1u); break; } }
    }
    nloc = mine > 0u ? mine : 1u; nx = cnt > 0u ? cnt : 1u;
}
__device__ __forceinline__ void xcd_barrier(unsigned* bar, volatile LAS unsigned* st) {
    asm volatile("s_waitcnt vmcnt(0)" ::: "memory");
    __syncthreads();
    if (threadIdx.x == 0) {
        __builtin_amdgcn_s_waitcnt(0);
        const unsigned x = xb_xcc_id();
        unsigned nloc = st[0], nx = st[1];
        if (nloc == 0u) { xcd_barrier_complete(bar, x, nloc, nx); st[0] = nloc; st[1] = nx; }
        const unsigned old = xb_add(&bar[XB_XSUB(x)], 1u);
        const unsigned gen = old / nloc;
        if (old + 1u == (gen + 1u) * nloc) {
            __builtin_amdgcn_fence(__ATOMIC_RELEASE, "agent");
            asm volatile("s_waitcnt vmcnt(0)" ::: "memory");
            const unsigned og = xb_add(&bar[XB_TOP], 1u);
            const unsigned tg = og / nx;
            if (og + 1u == (tg + 1u) * nx) xb_add(&bar[XB_TOPGEN], 1u);
            else XB_SPIN(xb_ld(&bar[XB_TOPGEN]) == tg, bar);
            __builtin_amdgcn_fence(__ATOMIC_ACQUIRE, "agent");
            xb_add(&bar[XB_XGEN(x)], 1u);
            asm volatile("s_waitcnt vmcnt(0)" ::: "memory");
        } else {
            XB_SPIN(xb_ld(&bar[XB_XGEN(x)]) == gen, bar);
            __builtin_amdgcn_fence(__ATOMIC_ACQUIRE, "agent");
            asm volatile("s_waitcnt vmcnt(0)" ::: "memory");
        }
    }
    __syncthreads();
}

namespace pg8 {
constexpr int BM = 256, BK = 64, HALF = 128, HTB = HALF * BK * 2, STAGE_BYTES = 8 * HTB, NXCD = 8, WGM = 8;
__device__ __forceinline__ int lds_byte(int r, int c) { const int st = (r >> 4) * 2 + (c >> 5), rr = r & 15, cc = c & 31, ob = rr * 64 + cc * 2; return st * 1024 + (ob ^ (((ob >> 9) & 1) << 5)); }
__device__ __forceinline__ void stage_rc(int b, int& R, int& C) { const int st = b / 1024, sb = b % 1024, swz = sb ^ (((sb >> 9) & 1) << 5); R = (st >> 1) * 16 + swz / 64; C = (st & 1) * 32 + (swz % 64) / 2; }
__device__ __forceinline__ int perm32(int rho) { const int n = rho >> 4, i = rho & 15; return 8 * (i >> 2) + 4 * n + (i & 3); }
struct Unit { int pm, pn, k0, nt; };
struct Gemm { const bf16_t* A; const bf16_t* Bt; int lda, ldb; size_t kstepA, kstepB, tstepA, tstepB; };
__device__ __forceinline__ Gemm gemm_rm(const bf16_t* A, const bf16_t* Bt, int lda, int ldb) { return Gemm{A, Bt, lda, ldb, 128, 128, (size_t)512 * lda, (size_t)512 * ldb}; }
struct StaticOrder {
    int nM, nN, nwg, G, c, ntK;
    __device__ void init(int M, int N, int K, int G_, int c_) { nM = M / BM; nN = N / BM; nwg = nM * nN; G = G_; c = c_; ntK = K / BK; }
    __device__ bool next(int i, Unit& u) const {
        const long L = (long)i * G + c; if (L >= nwg) return false;
        int wgid = (int)L; { const int q = nwg / NXCD, r = nwg % NXCD, xcd = wgid % NXCD, off = wgid / NXCD; wgid = (xcd < r ? xcd * (q + 1) : r * (q + 1) + (xcd - r) * q) + off; }
        const int nig = WGM * nN, gid = wgid / nig, fm = gid * WGM, gsz = (nM - fm) < WGM ? (nM - fm) : WGM;
        u.pm = fm + ((wgid % nig) % gsz); u.pn = (wgid % nig) / gsz; u.k0 = 0; u.nt = ntK; return true;
    }
};
struct BatchedOrder {
    int nu, per, G, c, ntK;
    __device__ bool next(int i, Unit& u) const { int L = i * G + c; if (L >= nu) return false;
        if (G == 256 && nu == 160 && per == 5) { const int x = c & 7, slot = c >> 3; L = (4 * x + slot / 5) * 5 + slot % 5; }
        u.pm = L; u.pn = L / per; u.k0 = 0; u.nt = ntK; return true; }
};
struct SplitOrder {
    StaticOrder S0; int nN, nch, pm0;
    __device__ void init(int Mmain, int N, int K, int G_, int c_) { S0.init(Mmain, N, K, G_, c_); nN = N / BM; nch = K / 256; pm0 = Mmain / BM; }
    __device__ bool next(int i, Unit& u) const {
        if (S0.next(i, u)) return true;
        const int R = ((S0.nwg + S0.G - 1) / S0.G) * S0.G, s = i * S0.G + S0.c - R;
        if (s < 0 || s >= 2 * nN * nch) return false;
        u.pm = pm0 + s / (nN * nch); u.pn = (s / nch) % nN; u.k0 = (s % nch) * 256; u.nt = 4; return true;
    }
};
__device__ __forceinline__ unsigned cvt_pk_bf16(float lo, float hi) { unsigned r; asm volatile("v_cvt_pk_bf16_f32 %0, %1, %2" : "=v"(r) : "v"(lo), "v"(hi)); return r; }
struct NoMid { static constexpr bool ON = false; __device__ __forceinline__ void operator()(f32x4 (&)[2][2][4][2], const Unit&, int, int) const {} };

template <class Epi, class Sched, class Mid>
__device__ __forceinline__ void gemm_phase(LAS unsigned char* lds, const Gemm g, const Sched& S, const Epi& E, const Mid& MD) {
    const int tid = threadIdx.x, wid = __builtin_amdgcn_readfirstlane(tid >> 6), lane = tid & 63, wr = wid >> 2, wc = wid & 3, fr = lane & 15, fq = lane >> 4;
    unsigned voffA[2], voffB[2];
#pragma unroll
    for (int i = 0; i < 2; ++i) { int R, C; stage_rc(tid * 16 + i * 8192, R, C); const int Rb = Epi::PERM ? ((R & ~31) + perm32(R & 31)) : R;
        voffA[i] = (unsigned)(R * g.lda + C) * 2u; voffB[i] = (unsigned)(Rb * g.ldb + C) * 2u; }
    const size_t kstepA = g.kstepA, kstepB = g.kstepB;
    const size_t hstepA = (size_t)HALF * g.lda * 2, hstepB = (size_t)HALF * g.ldb * 2;
    const size_t tstepA = g.tstepA, tstepB = g.tstepB;
    const unsigned ldsw = (unsigned)wid * 1024u;
    const int aoff = lds_byte(wr * 64 + fr, fq * 8), boff = lds_byte(wc * 32 + fr, fq * 8);
#define PG8_SA(b, h) (((b) * 2 + (h)) * HTB)
#define PG8_SB(b, h) ((4 + (b) * 2 + (h)) * HTB)
#define PG8_STAGE(bufoff, gbase, voff) do { _Pragma("unroll") for (int _i = 0; _i < 2; ++_i) \
        __builtin_amdgcn_global_load_lds((const unsigned*)((const char*)(gbase) + (voff)[_i]), (LAS unsigned*)(lds + (bufoff) + ldsw + _i * 8192), 16, 0, 0); } while (0)
#define PG8_LDA(dst, b, h) do { _Pragma("unroll") for (int m = 0; m < 4; ++m) _Pragma("unroll") for (int k = 0; k < 2; ++k) dst[m][k] = *(const LAS bf16x8*)(lds + PG8_SA(b, h) + aoff + m * 2048 + k * 1024); } while (0)
#define PG8_LDB(dst, b, h) do { _Pragma("unroll") for (int n = 0; n < 2; ++n) _Pragma("unroll") for (int k = 0; k < 2; ++k) dst[n][k] = *(const LAS bf16x8*)(lds + PG8_SB(b, h) + boff + n * 2048 + k * 1024); } while (0)
#define PG8_MMA(ai, bj, At, Bt) do { __builtin_amdgcn_s_setprio(1); _Pragma("unroll") for (int m = 0; m < 4; ++m) _Pragma("unroll") for (int n = 0; n < 2; ++n) _Pragma("unroll") for (int k = 0; k < 2; ++k) \
        acc[ai][bj][m][n] = __builtin_amdgcn_mfma_f32_16x16x32_bf16(Bt[n][k], At[m][k], acc[ai][bj][m][n], 0, 0, 0); __builtin_amdgcn_s_setprio(0); } while (0)
#define PG8_WAIT_V(n) asm volatile("s_waitcnt vmcnt(" #n ")" ::: "memory")
#define PG8_WAIT_L(n) asm volatile("s_waitcnt lgkmcnt(" #n ")" ::: "memory")
#define PG8_BAR __builtin_amdgcn_s_barrier()
#define PG8_SCHED __builtin_amdgcn_sched_barrier(0)
    Unit cur, nxt; int ui = 0;
    if (!S.next(0, cur)) return;
    f32x4 acc[2][2][4][2];
#pragma unroll
    for (int a = 0; a < 2; ++a)
#pragma unroll
        for (int b = 0; b < 2; ++b)
#pragma unroll
            for (int m = 0; m < 4; ++m)
#pragma unroll
                for (int n = 0; n < 2; ++n) acc[a][b][m][n] = (f32x4){0.f, 0.f, 0.f, 0.f};
    bf16x8 At[4][2], B0[2][2], B1[2][2];
    const char* cA = (const char*)g.A + (size_t)cur.pm * tstepA + (size_t)(cur.k0 >> 6) * kstepA; const char* cB = (const char*)g.Bt + (size_t)cur.pn * tstepB + (size_t)(cur.k0 >> 6) * kstepB;
    PG8_STAGE(PG8_SB(0, 0), cB, voffB); PG8_STAGE(PG8_SA(0, 0), cA, voffA); PG8_STAGE(PG8_SB(0, 1), cB + hstepB, voffB); PG8_STAGE(PG8_SA(0, 1), cA + hstepA, voffA);
    if (wr == 1) PG8_BAR;
    PG8_WAIT_V(4); PG8_BAR;
    PG8_STAGE(PG8_SB(1, 0), cB + kstepB, voffB); PG8_STAGE(PG8_SA(1, 0), cA + kstepA, voffA); PG8_STAGE(PG8_SB(1, 1), cB + hstepB + kstepB, voffB);
    PG8_WAIT_V(6); PG8_BAR;
    for (;;) {
        const bool has_next = S.next(ui + 1, nxt);
        const char* nA = has_next ? (const char*)g.A + (size_t)nxt.pm * tstepA + (size_t)(nxt.k0 >> 6) * kstepA : cA; const char* nB = has_next ? (const char*)g.Bt + (size_t)nxt.pn * tstepB + (size_t)(nxt.k0 >> 6) * kstepB : cB;
        const int nt = cur.nt;
        for (int t = 0; t < nt; t += 2) {
            const bool last = (t == nt - 2);
            if constexpr (Mid::ON) { if (t == (nt >> 1)) MD(acc, cur, wr, fr); }
            const char* a1 = cA + (size_t)(t + 1) * kstepA;
            const char* a2 = last ? nA : cA + (size_t)(t + 2) * kstepA; const char* b2 = last ? nB : cB + (size_t)(t + 2) * kstepB;
            const char* a3 = a2 + kstepA; const char* b3 = b2 + kstepB;
            PG8_LDB(B0, 0, 0); PG8_SCHED; PG8_LDA(At, 0, 0); PG8_STAGE(PG8_SA(1, 1), a1 + hstepA, voffA);
            PG8_WAIT_L(8); PG8_BAR; PG8_WAIT_L(0); PG8_MMA(0, 0, At, B0); PG8_BAR; PG8_SCHED;
            PG8_LDB(B1, 0, 1); PG8_STAGE(PG8_SB(0, 0), b2, voffB);
            PG8_BAR; PG8_WAIT_L(0); PG8_MMA(0, 1, At, B1); PG8_BAR;
            PG8_LDA(At, 0, 1); PG8_STAGE(PG8_SA(0, 0), a2, voffA);
            PG8_BAR; PG8_WAIT_L(0); PG8_MMA(1, 0, At, B0); PG8_BAR; PG8_SCHED;
            PG8_STAGE(PG8_SB(0, 1), b2 + hstepB, voffB);
            PG8_WAIT_V(6); PG8_BAR; PG8_MMA(1, 1, At, B1); PG8_BAR;
            PG8_LDB(B0, 1, 0); PG8_SCHED; PG8_LDA(At, 1, 0); PG8_STAGE(PG8_SA(0, 1), a2 + hstepA, voffA);
            PG8_WAIT_L(8); PG8_BAR; PG8_WAIT_L(0); PG8_MMA(0, 0, At, B0); PG8_BAR; PG8_SCHED;
            PG8_LDB(B1, 1, 1); PG8_STAGE(PG8_SB(1, 0), b3, voffB);
            PG8_BAR; PG8_WAIT_L(0); PG8_MMA(0, 1, At, B1); PG8_BAR;
            PG8_LDA(At, 1, 1); PG8_STAGE(PG8_SA(1, 0), a3, voffA);
            PG8_BAR; PG8_WAIT_L(0); PG8_MMA(1, 0, At, B0); PG8_BAR; PG8_SCHED;
            PG8_STAGE(PG8_SB(1, 1), b3 + hstepB, voffB);
            PG8_WAIT_V(6); PG8_BAR; PG8_MMA(1, 1, At, B1); PG8_BAR;
        }
        E(acc, cur, wr, wc, fr, fq);
        if (!has_next) break;
#pragma unroll
        for (int a = 0; a < 2; ++a)
#pragma unroll
            for (int b = 0; b < 2; ++b)
#pragma unroll
                for (int m = 0; m < 4; ++m)
#pragma unroll
                    for (int n = 0; n < 2; ++n) acc[a][b][m][n] = (f32x4){0.f, 0.f, 0.f, 0.f};
        cur = nxt; cA = nA; cB = nB; ++ui;
    }
    PG8_WAIT_V(0);
    if (wr == 0) PG8_BAR;
    PG8_BAR;
#undef PG8_SA
#undef PG8_SB
#undef PG8_STAGE
#undef PG8_LDA
#undef PG8_LDB
#undef PG8_MMA
#undef PG8_WAIT_V
#undef PG8_WAIT_L
#undef PG8_BAR
#undef PG8_SCHED
}
}
using pg8::Unit;
typedef f32x4 Acc[2][2][4][2];
__device__ __forceinline__ size_t act_off(int r, int j) { return ((size_t)((r >> 8) * (FF / 64) + (j >> 6)) * 256 + (r & 255)) * 64 + (j & 63); }

struct EpiProj { static constexpr bool PERM = true; const float* r1; bf16_t* U; bf16_t* V; bf16_t* AG;
    __device__ __forceinline__ void operator()(const Acc& acc, const Unit& u, int wr, int wc, int fr, int fq) const {
        const int row0 = u.pm * 256 + wr * 64 + fr, colt = u.pn * 256 + wc * 32 + 8 * fq;
#pragma unroll
        for (int ai = 0; ai < 2; ++ai)
#pragma unroll
            for (int m = 0; m < 4; ++m) { const int r = row0 + ai * 128 + m * 16; const float s = r1[r];
#pragma unroll
                for (int bj = 0; bj < 2; ++bj) { const int c = colt + bj * 128; const f32x4 v0 = acc[ai][bj][m][0] * s, v1 = acc[ai][bj][m][1] * s;
                    u32x4 w; w.x = pg8::cvt_pk_bf16(v0[0], v0[1]); w.y = pg8::cvt_pk_bf16(v0[2], v0[3]); w.z = pg8::cvt_pk_bf16(v1[0], v1[1]); w.w = pg8::cvt_pk_bf16(v1[2], v1[3]);
                    bf16_t* dst;
                    if (u.pn < 2) dst = U + (size_t)r * 512 + c;
                    else if (u.pn < 4) dst = V + (size_t)r * 512 + (c - 512);
                    else { const int ch = c - 1024, gg = ch >> 4, ci0 = ch & 15; int c16, t; if (r < MPR) { c16 = r >> 4; t = r & 15; } else { c16 = 1024 + ((r - MPR) >> 2); t = 12 + (r & 3); }
                        dst = AG + ((size_t)(gg * MC16 + c16) * KY + t * 16 + ci0); }
                    *(u32x4*)dst = w; } }
    }
};
struct EpiE { static constexpr bool PERM = false; float* EB;
    __device__ __forceinline__ void operator()(const Acc& acc, const Unit& u, int wr, int wc, int fr, int fq) const {
        const int row0 = u.pm * 256 + wr * 64 + fr, col0 = wc * 32 + 4 * fq;
#pragma unroll
        for (int ai = 0; ai < 2; ++ai)
#pragma unroll
            for (int m = 0; m < 4; ++m) { float* rp = EB + (size_t)(row0 + ai * 128 + m * 16) * 128 + col0;
#pragma unroll
                for (int n = 0; n < 2; ++n) *(f32x4*)(rp + n * 16) = acc[ai][0][m][n]; }
    }
};
struct EpiY { static constexpr bool PERM = true; const bf16_t* AG; const float* dsk; bf16_t* GB;
    __device__ __forceinline__ void operator()(const Acc& acc, const Unit& u, int wr, int wc, int fr, int fq) const {
        asm volatile("" : "+v"(fr), "+v"(fq));
        const int gg = u.pn, row0 = u.pm * 256 + wr * 64 + fr, colt = wc * 32 + 8 * fq;
#pragma unroll
        for (int ai = 0; ai < 2; ++ai)
#pragma unroll
            for (int m = 0; m < 4; ++m) { const int r = row0 + ai * 128 + m * 16, c16 = r - gg * MC16;
#pragma unroll
                for (int bj = 0; bj < 2; ++bj) { const int cb = colt + bj * 128, t = cb >> 4, co0 = cb & 15;
                    int tok = -1; if (c16 < 1024) tok = c16 * 16 + t; else if (c16 < 1152 && t >= 12) tok = MPR + (c16 - 1024) * 4 + (t - 12);
                    if (tok >= 0) {
                        const u32x4 xw = *(const u32x4*)(AG + (size_t)r * KY + cb);
                        u32x4 w;
                        { const f32x4 d0 = *(const f32x4*)(dsk + gg * 16 + co0); const f32x4 a0 = acc[ai][bj][m][0];
                          w.x = pg8::cvt_pk_bf16(gelu_t(a0[0] + d0[0] * bflo(xw.x)), gelu_t(a0[1] + d0[1] * bfhi(xw.x))); w.y = pg8::cvt_pk_bf16(gelu_t(a0[2] + d0[2] * bflo(xw.y)), gelu_t(a0[3] + d0[3] * bfhi(xw.y))); }
                        { const f32x4 d1 = *(const f32x4*)(dsk + gg * 16 + co0 + 4); const f32x4 a1 = acc[ai][bj][m][1];
                          w.z = pg8::cvt_pk_bf16(gelu_t(a1[0] + d1[0] * bflo(xw.z)), gelu_t(a1[1] + d1[1] * bfhi(xw.z))); w.w = pg8::cvt_pk_bf16(gelu_t(a1[2] + d1[2] * bflo(xw.w)), gelu_t(a1[3] + d1[3] * bfhi(xw.w))); }
                        *(u32x4*)(GB + (size_t)tok * 512 + gg * 16 + co0) = w; } }
                asm volatile("" ::: "memory"); }
    }
};
struct EpiGlu { static constexpr bool PERM = true; const bf16_t* GB; const float* bglu; bf16_t* MIX; float* ssq;
    __device__ __forceinline__ void operator()(const Acc& acc, const Unit& u, int wr, int wc, int fr, int fq) const {
        const int row0 = u.pm * 256 + wr * 64 + fr, colt = u.pn * 256 + wc * 32 + 8 * fq;
#pragma unroll
        for (int ai = 0; ai < 2; ++ai)
#pragma unroll
            for (int m = 0; m < 4; ++m) { const int r = row0 + ai * 128 + m * 16; float sq = 0.f;
#pragma unroll
                for (int bj = 0; bj < 2; ++bj) { const int c = colt + bj * 128;
                    const u32x4 gw = *(const u32x4*)(GB + (size_t)r * 512 + c);
                    const f32x4 b0 = *(const f32x4*)(bglu + c), b1 = *(const f32x4*)(bglu + c + 4);
                    const f32x4 a0 = acc[ai][bj][m][0] + b0, a1 = acc[ai][bj][m][1] + b1;
                    float o[8]; o[0] = bflo(gw.x) * sigm(a0[0]); o[1] = bfhi(gw.x) * sigm(a0[1]); o[2] = bflo(gw.y) * sigm(a0[2]); o[3] = bfhi(gw.y) * sigm(a0[3]);
                    o[4] = bflo(gw.z) * sigm(a1[0]); o[5] = bfhi(gw.z) * sigm(a1[1]); o[6] = bflo(gw.w) * sigm(a1[2]); o[7] = bfhi(gw.w) * sigm(a1[3]);
#pragma unroll
                    for (int e = 0; e < 8; ++e) sq += o[e] * o[e];
                    u32x4 w; w.x = pg8::cvt_pk_bf16(o[0], o[1]); w.y = pg8::cvt_pk_bf16(o[2], o[3]); w.z = pg8::cvt_pk_bf16(o[4], o[5]); w.w = pg8::cvt_pk_bf16(o[6], o[7]);
                    *(u32x4*)(MIX + (size_t)r * 1024 + c) = w; }
                sq += __shfl_xor(sq, 16); sq += __shfl_xor(sq, 32);
                if (fq == 0) atomicAdd(ssq + r, sq); }
    }
};
struct MidOut { static constexpr bool ON = true; const float* ssqb;
    __device__ __forceinline__ void operator()(Acc& acc, const Unit& u, int wr, int fr) const {
        if (u.nt != 16) return;
        const int row0 = u.pm * 256 + wr * 64 + fr;
#pragma unroll
        for (int ai = 0; ai < 2; ++ai)
#pragma unroll
            for (int m = 0; m < 4; ++m) { const float s = rsqrtf(ssqb[row0 + ai * 128 + m * 16] * (1.0f / 512.0f) + EPS);
#pragma unroll
                for (int bj = 0; bj < 2; ++bj)
#pragma unroll
                    for (int n = 0; n < 2; ++n) acc[ai][bj][m][n] *= s; }
    }
};
struct EpiOut { static constexpr bool PERM = true; const float* xp; const float* xs; float* H; bf16_t* HB; float* ssq; const float* ssqb; float* PART; const bf16_t* XB;
    __device__ __forceinline__ void operator()(const Acc& acc, const Unit& u, int wr, int wc, int fr, int fq) const {
        const int row0 = u.pm * 256 + wr * 64 + fr, colt = u.pn * 256 + wc * 32 + 8 * fq;
        if (u.nt != 16) {
#pragma unroll
            for (int ai = 0; ai < 2; ++ai)
#pragma unroll
                for (int m = 0; m < 4; ++m) { const int r = row0 + ai * 128 + m * 16; const float s = (u.k0 < 512) ? rsqrtf(ssqb[r] * (1.0f / 512.0f) + EPS) : 1.0f;
#pragma unroll
                    for (int bj = 0; bj < 2; ++bj) { float* q = PART + ((size_t)(u.k0 >> 8) * 512 + (r - MPR)) * 1024 + colt + bj * 128;
                        *(f32x4*)q = acc[ai][bj][m][0] * s; *(f32x4*)(q + 4) = acc[ai][bj][m][1] * s; } }
            return;
        }
#pragma unroll
        for (int ai = 0; ai < 2; ++ai)
#pragma unroll
            for (int m = 0; m < 4; ++m) { const int r = row0 + ai * 128 + m * 16; float sq = 0.f;
#pragma unroll
                for (int bj = 0; bj < 2; ++bj) { const int c = colt + bj * 128;
                    const u32x4 xw = *(const u32x4*)(XB + (size_t)r * 1024 + c);
                    const f32x4 h0 = (f32x4){bflo(xw.x), bfhi(xw.x), bflo(xw.y), bfhi(xw.y)} + acc[ai][bj][m][0], h1 = (f32x4){bflo(xw.z), bfhi(xw.z), bflo(xw.w), bfhi(xw.w)} + acc[ai][bj][m][1];
                    sq += h0[0] * h0[0] + h0[1] * h0[1] + h0[2] * h0[2] + h0[3] * h0[3] + h1[0] * h1[0] + h1[1] * h1[1] + h1[2] * h1[2] + h1[3] * h1[3];
                    u32x4 w; w.x = pg8::cvt_pk_bf16(h0[0], h0[1]); w.y = pg8::cvt_pk_bf16(h0[2], h0[3]); w.z = pg8::cvt_pk_bf16(h1[0], h1[1]); w.w = pg8::cvt_pk_bf16(h1[2], h1[3]);
                    *(u32x4*)(HB + (size_t)r * 1024 + c) = w; }
                sq += __shfl_xor(sq, 16); sq += __shfl_xor(sq, 32);
                if (fq == 0) atomicAdd(ssq + r, sq); }
    }
};
struct EpiUp { static constexpr bool PERM = true; const float* ssqh; bf16_t* ACT; bf16_t* HALO; bf16_t* HEAD; bf16_t* UPS; float* out; const float* cw; const float* cb;
    __device__ __forceinline__ void operator()(Acc& acc, const Unit& u, int wr, int wc, int fr, int fq) const {
        const int row0 = u.pm * 256 + wr * 64 + fr, j0 = u.pn * 128 + wc * 32 + 8 * fq;
#pragma unroll
        for (int ai = 0; ai < 2; ++ai)
#pragma unroll
            for (int m = 0; m < 4; ++m) { const float s = rsqrtf(ssqh[row0 + ai * 128 + m * 16] * (1.0f / 1024.0f) + EPS);
#pragma unroll
                for (int bj = 0; bj < 2; ++bj)
#pragma unroll
                    for (int n = 0; n < 2; ++n) acc[ai][bj][m][n] *= s; }
        if (u.pm >= 64) {
#pragma unroll
            for (int ai = 0; ai < 2; ++ai)
#pragma unroll
                for (int m = 0; m < 4; ++m) { const int rs = row0 + ai * 128 + m * 16 - MPR, j = rs & 3;
#pragma unroll
                    for (int bj = 0; bj < 2; ++bj) { const f32x4 v0 = acc[ai][bj][m][0], v1 = acc[ai][bj][m][1]; const int c = bj * FF + j0;
                        u32x4 w; w.x = pg8::cvt_pk_bf16(v0[0], v0[1]); w.y = pg8::cvt_pk_bf16(v0[2], v0[3]); w.z = pg8::cvt_pk_bf16(v1[0], v1[1]); w.w = pg8::cvt_pk_bf16(v1[2], v1[3]);
                        *(u32x4*)(UPS + (size_t)rs * FF2 + c) = w;
                        if (j >= 2) { float* o = out + O_CS + ((size_t)((rs >> 2) * 2 + (j - 2))) * FF2 + c; *(f32x4*)o = v0; *(f32x4*)(o + 4) = v1; } } }
            return;
        }
#pragma unroll
        for (int ai = 0; ai < 2; ++ai) { const int rb = row0 + ai * 128;
            if (fr >= 14) { const int r = rb + 48, k = r >> 6, pos = r & 2047;
#pragma unroll
                for (int bj = 0; bj < 2; ++bj) { const f32x4 v0 = acc[ai][bj][3][0], v1 = acc[ai][bj][3][1]; const int c = bj * FF + j0;
                    u32x4 w; w.x = pg8::cvt_pk_bf16(v0[0], v0[1]); w.y = pg8::cvt_pk_bf16(v0[2], v0[3]); w.z = pg8::cvt_pk_bf16(v1[0], v1[1]); w.w = pg8::cvt_pk_bf16(v1[2], v1[3]);
                    *(u32x4*)(HALO + (size_t)(k * 2 + (fr - 14)) * FF2 + c) = w;
                    if (pos >= 2046) { float* o = out + O_CP + ((size_t)((r >> 11) * 2 + (pos - 2046))) * FF2 + c; *(f32x4*)o = v0; *(f32x4*)(o + 4) = v1; } } }
            if (fr < 2) { const int k = rb >> 6;
#pragma unroll
                for (int bj = 0; bj < 2; ++bj) { const f32x4 v0 = acc[ai][bj][0][0], v1 = acc[ai][bj][0][1]; const int c = bj * FF + j0;
                    u32x4 w; w.x = pg8::cvt_pk_bf16(v0[0], v0[1]); w.y = pg8::cvt_pk_bf16(v0[2], v0[3]); w.z = pg8::cvt_pk_bf16(v1[0], v1[1]); w.w = pg8::cvt_pk_bf16(v1[2], v1[3]);
                    *(u32x4*)(HEAD + (size_t)(k * 2 + fr) * FF2 + c) = w; } } }
        u32x2 keep[2][4];
#pragma unroll
        for (int n = 0; n < 2; ++n) { const int j = j0 + 4 * n;
            const f32x4 wg0 = *(const f32x4*)(cw + j), wg1 = *(const f32x4*)(cw + FF2 + j), wg2 = *(const f32x4*)(cw + 2 * FF2 + j), bg = *(const f32x4*)(cb + j);
            const f32x4 wv0 = *(const f32x4*)(cw + FF + j), wv1 = *(const f32x4*)(cw + FF2 + FF + j), wv2 = *(const f32x4*)(cw + 2 * FF2 + FF + j), bv = *(const f32x4*)(cb + FF + j);
#pragma unroll
            for (int ai = 0; ai < 2; ++ai)
#pragma unroll
                for (int m = 0; m < 4; ++m) { const f32x4 cg = acc[ai][0][m][n], cv = acc[ai][1][m][n];
                    const f32x4 pg = acc[ai][0][m > 0 ? m - 1 : 0][n], pv = acc[ai][1][m > 0 ? m - 1 : 0][n];
                    f32x4 g1, g2, v1, v2;
#pragma unroll
                    for (int e = 0; e < 4; ++e) {
                        g1[e] = dpps<0x111>(dppf<0x121>(pg[e]), cg[e]); g2[e] = dpps<0x112>(dppf<0x122>(pg[e]), cg[e]);
                        v1[e] = dpps<0x111>(dppf<0x121>(pv[e]), cv[e]); v2[e] = dpps<0x112>(dppf<0x122>(pv[e]), cv[e]); }
                    const f32x4 ga = bg + wg0 * g2 + wg1 * g1 + wg2 * cg, va = bv + wv0 * v2 + wv1 * v1 + wv2 * cv;
                    const f32x4 zz = (ga + ga * ga * ga * 0.044715f) * (-2.3022082f);
                    f32x4 o;
#pragma unroll
                    for (int e = 0; e < 4; ++e) o[e] = __builtin_amdgcn_rcpf(1.0f + __builtin_amdgcn_exp2f(zz[e]));
                    o = o * ga * va;
                    u32x2 w; w.x = pg8::cvt_pk_bf16(o[0], o[1]); w.y = pg8::cvt_pk_bf16(o[2], o[3]);
                    if (n == 0) keep[ai][m] = w;
                    else { u32x4 w4; w4.x = keep[ai][m].x; w4.y = keep[ai][m].y; w4.z = w.x; w4.w = w.y; *(u32x4*)(ACT + act_off(row0 + ai * 128 + m * 16, j0)) = w4; asm volatile("" ::: "memory"); } } }
    }
};
struct EpiDown { static constexpr bool PERM = true; float* H; float* ssq; const bf16_t* HB; float* PART; bf16_t* HBW;
    __device__ __forceinline__ void operator()(const Acc& acc, const Unit& u, int wr, int wc, int fr, int fq) const {
        const int row0 = u.pm * 256 + wr * 64 + fr, colt = u.pn * 256 + wc * 32 + 8 * fq;
        const bool partial = (u.nt != FF / 64);
#pragma unroll
        for (int ai = 0; ai < 2; ++ai)
#pragma unroll
            for (int m = 0; m < 4; ++m) { const int r = row0 + ai * 128 + m * 16; float sq = 0.f;
#pragma unroll
                for (int bj = 0; bj < 2; ++bj) { const int c = colt + bj * 128; f32x4 h0 = acc[ai][bj][m][0], h1 = acc[ai][bj][m][1];
                    if (!partial || u.k0 == 0) { const u32x4 hw = *(const u32x4*)(HB + (size_t)r * 1024 + c);
                        h0 += (f32x4){bflo(hw.x), bfhi(hw.x), bflo(hw.y), bfhi(hw.y)}; h1 += (f32x4){bflo(hw.z), bfhi(hw.z), bflo(hw.w), bfhi(hw.w)}; }
                    if (partial) { float* q = PART + ((size_t)(u.k0 >> 8) * 512 + (r - MPR)) * 1024 + c; *(f32x4*)q = h0; *(f32x4*)(q + 4) = h1; }
                    else { sq += h0[0] * h0[0] + h0[1] * h0[1] + h0[2] * h0[2] + h0[3] * h0[3] + h1[0] * h1[0] + h1[1] * h1[1] + h1[2] * h1[2] + h1[3] * h1[3];
                        u32x4 w; w.x = pg8::cvt_pk_bf16(h0[0], h0[1]); w.y = pg8::cvt_pk_bf16(h0[2], h0[3]); w.z = pg8::cvt_pk_bf16(h1[0], h1[1]); w.w = pg8::cvt_pk_bf16(h1[2], h1[3]);
                        *(u32x4*)(HBW + (size_t)r * 1024 + c) = w; } }
                if (!partial) { sq += __shfl_xor(sq, 16); sq += __shfl_xor(sq, 32); if (fq == 0) atomicAdd(ssq + r, sq); } }
    }
};

__device__ __forceinline__ void tr_tile(const float* src, int N, int k0, int n0, bf16_t* dst, int ldd, int kd0, const float* sc, LAS float* tile, int tid, int dn0 = -1) {
    if (dn0 < 0) dn0 = n0;
    { const int tr = tid >> 5, tc = tid & 31; float4 v[4];
#pragma unroll
      for (int i = 0; i < 4; ++i) v[i] = *(const float4*)(src + (size_t)(k0 + tr + i * 16) * N + n0 + tc * 4);
#pragma unroll
      for (int i = 0; i < 4; ++i) { const int k = tr + i * 16; const float s = sc ? sc[k] : 1.0f;
          tile[k * 129 + tc * 4 + 0] = v[i].x * s; tile[k * 129 + tc * 4 + 1] = v[i].y * s; tile[k * 129 + tc * 4 + 2] = v[i].z * s; tile[k * 129 + tc * 4 + 3] = v[i].w * s; } }
    __syncthreads();
#pragma unroll
    for (int h = 0; h < 2; ++h) { const int wn = (tid >> 3) + h * 64, wk = tid & 7; float e[8];
#pragma unroll
      for (int j = 0; j < 8; ++j) e[j] = tile[(wk * 8 + j) * 129 + wn];
      u32x4 w; w.x = pk2(e[0], e[1]); w.y = pk2(e[2], e[3]); w.z = pk2(e[4], e[5]); w.w = pk2(e[6], e[7]);
      *(u32x4*)(dst + (size_t)(dn0 + wn) * ldd + kd0 + wk * 8) = w; }
    __syncthreads();
}

__device__ __forceinline__ void ssm_prep(KP kp, int g, int half, LAS float* L, int tid) {
    LAS float* apr = L;
    LAS float* api = L + 17 * 64;
    LAS float* bbr = L + 2 * 17 * 64;
    LAS float* bbi = bbr + 1024;
    LAS float* crr = bbi + 1024;
    LAS float* cii = crr + 1024;
    LAS float* frs = cii + 1024;
    LAS float* fis = frs + 64;
    LAS float* ktau = fis + 64;
    unsigned char* ws = p.ws;
    if (tid < 64) {
        const float dt = expf(p.log_dt[g]); const float lr = p.lam_re[g * 64 + tid], li = p.lam_im[g * 64 + tid];
        const float mag = expf(lr * dt), ang = li * dt; const float ar = mag * cosf(ang), ai = mag * sinf(ang);
        const float den = lr * lr + li * li;
        frs[tid] = ((ar - 1.0f) * lr + ai * li) / den; fis[tid] = (ai * lr - (ar - 1.0f) * li) / den;
        float pr = 1.f, pi = 0.f;
        for (int t = 0; t <= 16; ++t) { apr[t * 64 + tid] = pr; api[t * 64 + tid] = pi; const float nr = pr * ar - pi * ai, ni = pr * ai + pi * ar; pr = nr; pi = ni; }
        if (half == 0) { ((float*)(ws + W_A16))[g * 64 + tid] = apr[16 * 64 + tid]; ((float*)(ws + W_A16))[2048 + g * 64 + tid] = api[16 * 64 + tid]; }
        const float m2 = ar * ar + ai * ai; const float ir = ar / m2, ii = -ai / m2; float qr = 1.f, qi = 0.f;
        for (int t = 0; t < 12; ++t) { const float nr = qr * ir - qi * ii, ni = qr * ii + qi * ir; qr = nr; qi = ni; }
        if (half == 0) { ((float*)(ws + W_AM12))[g * 64 + tid] = qr; ((float*)(ws + W_AM12))[2048 + g * 64 + tid] = qi; }
    }
    for (int i = tid; i < 1024; i += 512) { crr[i] = p.c_re[g * 1024 + i]; cii[i] = p.c_im[g * 1024 + i]; }
    __syncthreads();
    for (int i = tid; i < 1024; i += 512) { const int pp = i >> 4; const float br = p.b_re[g * 1024 + i], bi = p.b_im[g * 1024 + i];
        bbr[i] = frs[pp] * br - fis[pp] * bi; bbi[i] = frs[pp] * bi + fis[pp] * br; }
    __syncthreads();
    for (int i2 = tid; i2 < 2048; i2 += 512) { const int tau = i2 >> 7, co = half * 8 + ((i2 >> 4) & 7), ci = i2 & 15, i = tau * 256 + co * 16 + ci; float s = 0.f;
        for (int pp = 0; pp < 64; ++pp) { const float cr = crr[co * 64 + pp], cim = cii[co * 64 + pp], pr = apr[tau * 64 + pp], pi = api[tau * 64 + pp];
            const float xr = cr * pr - cim * pi, xi = cr * pi + cim * pr; s += xr * bbr[pp * 16 + ci] - xi * bbi[pp * 16 + ci]; }
        ktau[i] = s; }
    __syncthreads();
    bf16_t* WY = (bf16_t*)(ws + W_WY) + (size_t)g * 256 * KY;
    for (int i = tid; i < 128 * 48; i += 512) { const int n2 = i / 48, k0 = (i % 48) * 8, t = n2 >> 3, co = half * 8 + (n2 & 7), n = t * 16 + co; float e[8];
        if (k0 < 256) { const int s = k0 >> 4, ci0 = k0 & 15;
#pragma unroll
            for (int j = 0; j < 8; ++j) e[j] = (t >= s) ? ktau[(t - s) * 256 + co * 16 + ci0 + j] : 0.f; }
        else { const int kk = k0 - 256, ri = kk >> 6, p0 = kk & 63;
#pragma unroll
            for (int j = 0; j < 8; ++j) { const int pp = p0 + j; const float cr = crr[co * 64 + pp], cim = cii[co * 64 + pp], pr = apr[(t + 1) * 64 + pp], pi = api[(t + 1) * 64 + pp];
                e[j] = ri == 0 ? (cr * pr - cim * pi) : -(cr * pi + cim * pr); } }
        u32x4 w; w.x = pk2(e[0], e[1]); w.y = pk2(e[2], e[3]); w.z = pk2(e[4], e[5]); w.w = pk2(e[6], e[7]);
        *(u32x4*)(WY + (size_t)n * KY + k0) = w; }
    bf16_t* WE = (bf16_t*)(ws + W_WE) + (size_t)g * 256 * 256;
    for (int i = tid; i < 64 * 32; i += 512) { const int ri = half, pp = i >> 5, n = ri * 64 + pp, k0 = (i & 31) * 8, s = k0 >> 4, ci0 = k0 & 15; float e[8];
        const float pr = apr[(15 - s) * 64 + pp], pi = api[(15 - s) * 64 + pp];
#pragma unroll
        for (int j = 0; j < 8; ++j) { const float br = bbr[pp * 16 + ci0 + j], bi = bbi[pp * 16 + ci0 + j]; e[j] = ri == 0 ? (pr * br - pi * bi) : (pr * bi + pi * br); }
        u32x4 w; w.x = pk2(e[0], e[1]); w.y = pk2(e[2], e[3]); w.z = pk2(e[4], e[5]); w.w = pk2(e[6], e[7]);
        *(u32x4*)(WE + (size_t)n * 256 + k0) = w; }
    __syncthreads();
}

__device__ __forceinline__ void tr_do(KP kp, LAS float* tile, int tid, int ti) {
    unsigned char* ws = p.ws;
    if (ti < 192) { const int kt = ti / 12, nt = ti % 12; tr_tile(p.w_in, NPROJ, kt * 64, nt * 128, (bf16_t*)(ws + W_WIN), 1024, kt * 64, p.g_mix + kt * 64, tile, tid); }
    else if (ti < 224) { const int t2 = ti - 192, kt = t2 / 4, nt = t2 % 4; tr_tile(p.w_glu, 512, kt * 64, nt * 128, (bf16_t*)(ws + W_WGLU), 512, kt * 64, nullptr, tile, tid); }
    else if (ti < 352) { const int t2 = ti - 224, kt = t2 / 8, nt = t2 % 8; const int k0 = kt * 64;
        tr_tile(p.w_out, 1024, k0, nt * 128, (bf16_t*)(ws + W_WOUT), 1024, (k0 + 512) & 1023, k0 < 512 ? p.g_out_a + k0 : p.g_out_b + (k0 - 512), tile, tid); }
    else if (ti < 1056) { const int t2 = ti - 352, kt = t2 / 44, nt = t2 % 44; const int jn = nt * 128, hb = jn >= FF ? 1 : 0, jj = jn - hb * FF;
        tr_tile(p.w_ffn_in, FF2, kt * 64, jn, (bf16_t*)(ws + W_WUP), 1024, kt * 64, p.g_ffn + kt * 64, tile, tid, (jj >> 7) * 256 + hb * 128); }
    else { const int t2 = ti - 1056, kt = t2 / 8, nt = t2 % 8, n0 = nt * 128;
        tr_tile(p.w_ffn_out, 1024, kt * 64, n0, (bf16_t*)(ws + W_WDN), 64, 0, nullptr, tile, tid, ((n0 >> 8) * (FF / 64) + kt) * 256 + (n0 & 255)); }
}
__device__ __forceinline__ void tr_range(KP kp, LAS unsigned char* lds, int lo, int hi, int idx, int stride) {
    __syncthreads();
    for (int ti = lo + idx; ti < hi; ti += stride) tr_do(kp, (LAS float*)lds, threadIdx.x, ti);
}

__device__ __forceinline__ void phase0(KP kp, LAS unsigned char* lds) {
    const int tid = threadIdx.x, bid = blockIdx.x, G = gridDim.x, lane = tid & 63, wid = tid >> 6;
    unsigned char* ws = p.ws;
    { const int gt = bid * 512 + tid, GT = G * 512;
      float* z = (float*)(ws + W_SSQB); for (int i = gt; i < 3 * MTOK; i += GT) z[i] = 0.f;
      float* za = (float*)(ws + W_SSQA); for (int i = gt; i < MTOK; i += GT) za[i] = 0.f;
      bf16_t* wt = (bf16_t*)(ws + W_WTRIL); for (int i = gt; i < 65536; i += GT) { const int t = (i >> 7) & 127, s = i & 127; wt[i] = f2bf(s <= t ? p.w_s[i] : 0.f); }
      unsigned* ag = (unsigned*)(ws + W_AG);
      for (int i = gt; i < 32 * 128 * 96; i += GT) { const int gg = i / (128 * 96), rem = i % (128 * 96), b = rem / 96, k2 = rem % 96; ag[((size_t)(gg * MC16 + 1024 + b) * KY) / 2 + k2] = 0u; } }
    { bf16_t* XB = (bf16_t*)(ws + W_XB); float* R1 = (float*)(ws + W_R1);
      for (int row = (bid * 8 + wid) * 2; row < MTOK; row += G * 16) {
          float4 v[2][4]; float sq[2] = {0.f, 0.f};
#pragma unroll
          for (int rr = 0; rr < 2; ++rr) { const int r = row + rr; const float* src = r < MPR ? p.x_prompt + (size_t)r * 1024 : p.x_sample + (size_t)(r - MPR) * 1024;
#pragma unroll
              for (int i = 0; i < 2; ++i) { const f32x4 a_ = __builtin_nontemporal_load((const f32x4*)(src + i * 512 + lane * 8)), b_ = __builtin_nontemporal_load((const f32x4*)(src + i * 512 + lane * 8 + 4));
                  v[rr][2 * i] = make_float4(a_[0], a_[1], a_[2], a_[3]); v[rr][2 * i + 1] = make_float4(b_[0], b_[1], b_[2], b_[3]); } }
#pragma unroll
          for (int rr = 0; rr < 2; ++rr) {
#pragma unroll
              for (int i = 0; i < 4; ++i) sq[rr] += v[rr][i].x * v[rr][i].x + v[rr][i].y * v[rr][i].y + v[rr][i].z * v[rr][i].z + v[rr][i].w * v[rr][i].w;
#pragma unroll
              for (int o = 32; o >= 1; o >>= 1) sq[rr] += __shfl_xor(sq[rr], o);
              if (lane == 0) R1[row + rr] = rsqrtf(sq[rr] * (1.0f / 1024.0f) + EPS);
#pragma unroll
              for (int i = 0; i < 2; ++i) { u32x4 w; w.x = pk2(v[rr][2 * i].x, v[rr][2 * i].y); w.y = pk2(v[rr][2 * i].z, v[rr][2 * i].w); w.z = pk2(v[rr][2 * i + 1].x, v[rr][2 * i + 1].y); w.w = pk2(v[rr][2 * i + 1].z, v[rr][2 * i + 1].w);
                  *(u32x4*)(XB + (size_t)(row + rr) * 1024 + i * 512 + lane * 8) = w; } } } }
    LAS float* tile = (LAS float*)lds;
    for (int ti = bid; ti < 192; ti += G) tr_do(kp, tile, tid, ti);
}

__device__ __forceinline__ void sgu_phase(KP kp, LAS unsigned char* lds, int first_item_offset) {
    const int tid = threadIdx.x, G = gridDim.x, lane = tid & 63, wid = tid >> 6, fr = lane & 15, fq = lane >> 4;
    unsigned char* ws = p.ws;
    const bf16_t* U = (const bf16_t*)(ws + W_U); const bf16_t* V = (const bf16_t*)(ws + W_V); const bf16_t* WT = (const bf16_t*)(ws + W_WTRIL);
    bf16_t* AOUT = (bf16_t*)(ws + W_AOUT); float* SSQA = (float*)(ws + W_SSQA);
    LAS bf16_t* vnT = (LAS bf16_t*)lds;
    const bool free_wg = (G == 256) && ((int)blockIdx.x >= first_item_offset);
    const int it0 = (G == 256) ? (free_wg ? (int)blockIdx.x - first_item_offset : 384 + (int)blockIdx.x) : (int)blockIdx.x;
    const int itstep = (G == 256) ? (free_wg ? G - first_item_offset : 1024) : G, itend = (G == 256 && free_wg) ? 384 : 516;
    for (int item = it0; item < itend; item += itstep) {
        if (item < 512) {
            const int t0 = (item >> 2) * 128, tb = wid, trow = tb * 16 + fr;
            float sq = 0.f;
            { const int h = item & 3;
                const int nk = (tb >> 1) + 1; bf16x8 wfr[4];
#pragma unroll
                for (int ks = 0; ks < 4; ++ks) if (ks < nk) wfr[ks] = *(const bf16x8*)(WT + (size_t)(h * 128 + trow) * 128 + ks * 32 + fq * 8);
                { const int row = tid >> 2, q = tid & 3; const bf16_t* vp = V + (size_t)(t0 + row) * 512 + h * 128 + q * 32;
                  u32x4 w[4]; float s2 = 0.f;
#pragma unroll
                  for (int i = 0; i < 4; ++i) { w[i] = *(const u32x4*)(vp + i * 8);
                      const float a0 = bflo(w[i].x), a1 = bfhi(w[i].x), a2 = bflo(w[i].y), a3 = bfhi(w[i].y), a4 = bflo(w[i].z), a5 = bfhi(w[i].z), a6 = bflo(w[i].w), a7 = bfhi(w[i].w);
                      s2 += a0 * a0 + a1 * a1 + a2 * a2 + a3 * a3 + a4 * a4 + a5 * a5 + a6 * a6 + a7 * a7; }
                  s2 += __shfl_xor(s2, 1); s2 += __shfl_xor(s2, 2);
                  const float rs = rsqrtf(s2 * (1.0f / 128.0f) + EPS); const float* gv = p.g_v + h * 128 + q * 32;
#pragma unroll
                  for (int i = 0; i < 4; ++i) { const unsigned ww[4] = {w[i].x, w[i].y, w[i].z, w[i].w};
#pragma unroll
                      for (int j = 0; j < 4; ++j) { const int d = q * 32 + i * 8 + j * 2;
                          vnT[d * 136 + row] = f2bf(bflo(ww[j]) * rs * gv[i * 8 + j * 2]); vnT[(d + 1) * 136 + row] = f2bf(bfhi(ww[j]) * rs * gv[i * 8 + j * 2 + 1]); } } }
                __syncthreads();
                f32x4 acc[8];
#pragma unroll
                for (int db = 0; db < 8; ++db) acc[db] = (f32x4){0.f, 0.f, 0.f, 0.f};
#pragma unroll
                for (int ks = 0; ks < 4; ++ks) if (ks < nk) {
                    const bf16x8 wf = wfr[ks];
#pragma unroll
                    for (int db = 0; db < 8; ++db) { const bf16x8 xf = *(const LAS bf16x8*)(vnT + (db * 16 + fr) * 136 + ks * 32 + fq * 8);
                        acc[db] = __builtin_amdgcn_mfma_f32_16x16x32_bf16(xf, wf, acc[db], 0, 0, 0); }
                }
                const float bs = p.b_s[h * 128 + trow];
#pragma unroll
                for (int db = 0; db < 8; ++db) { const u32x2 uw = *(const u32x2*)(U + (size_t)(t0 + trow) * 512 + h * 128 + db * 16 + 4 * fq);
                    const float a0 = bflo(uw.x) * (acc[db][0] + bs), a1 = bfhi(uw.x) * (acc[db][1] + bs), a2 = bflo(uw.y) * (acc[db][2] + bs), a3 = bfhi(uw.y) * (acc[db][3] + bs);
                    sq += a0 * a0 + a1 * a1 + a2 * a2 + a3 * a3; u32x2 w; w.x = pk2(a0, a1); w.y = pk2(a2, a3);
                    *(u32x2*)(AOUT + (size_t)(t0 + trow) * 512 + h * 128 + db * 16 + 4 * fq) = w;
#ifdef SGU_DIRECT
                    *(f32x4*)((float*)(ws + W_HB) + (size_t)(t0 + trow) * 512 + h * 128 + db * 16 + 4 * fq) = (f32x4){a0, a1, a2, a3};
#endif
 }
                __syncthreads();
            }
            sq += __shfl_xor(sq, 16); sq += __shfl_xor(sq, 32);
            if (fq == 0) atomicAdd(SSQA + t0 + trow, sq);
        } else {
            const int sc = item - 512, sqn = tid >> 4, h = (tid >> 2) & 3, dq = tid & 3, b = sc * 32 + sqn, row0 = MPR + b * 4;
            float rs[4];
#pragma unroll
            for (int j = 0; j < 4; ++j) { const bf16_t* vp = V + (size_t)(row0 + j) * 512 + h * 128 + dq * 32; float s2 = 0.f;
#pragma unroll
                for (int i = 0; i < 4; ++i) { const u32x4 w = *(const u32x4*)(vp + i * 8); const unsigned ww[4] = {w.x, w.y, w.z, w.w};
#pragma unroll
                    for (int k = 0; k < 4; ++k) { const float a = bflo(ww[k]), c = bfhi(ww[k]); s2 += a * a + c * c; } }
                s2 += __shfl_xor(s2, 1); s2 += __shfl_xor(s2, 2); rs[j] = rsqrtf(s2 * (1.0f / 128.0f) + EPS); }
            float wsj[4][4], bsj[4];
#pragma unroll
            for (int j = 0; j < 4; ++j) { bsj[j] = p.b_s[h * 128 + j];
#pragma unroll
                for (int k = 0; k < 4; ++k) wsj[j][k] = (k <= j) ? p.w_s[(size_t)(h * 128 + j) * 128 + k] : 0.f; }
            float ssa[4] = {0.f, 0.f, 0.f, 0.f};
            { const int sweep = 0;
                for (int i = 0; i < 4; ++i) { const int d0 = dq * 32 + i * 8; float vn[4][8];
#pragma unroll
                    for (int j = 0; j < 4; ++j) { const u32x4 w = *(const u32x4*)(V + (size_t)(row0 + j) * 512 + h * 128 + d0); const unsigned ww[4] = {w.x, w.y, w.z, w.w};
#pragma unroll
                        for (int k = 0; k < 4; ++k) { vn[j][2 * k] = bflo(ww[k]) * rs[j] * p.g_v[h * 128 + d0 + 2 * k]; vn[j][2 * k + 1] = bfhi(ww[k]) * rs[j] * p.g_v[h * 128 + d0 + 2 * k + 1]; }
                        if (sweep == 0) { float* o = p.out + O_VS + ((size_t)((b * 4 + j) * 4 + h)) * 128 + d0;
                            *(f32x4*)o = (f32x4){vn[j][0], vn[j][1], vn[j][2], vn[j][3]}; *(f32x4*)(o + 4) = (f32x4){vn[j][4], vn[j][5], vn[j][6], vn[j][7]}; } }
#pragma unroll
                    for (int j = 0; j < 4; ++j) { const u32x4 uw = *(const u32x4*)(U + (size_t)(row0 + j) * 512 + h * 128 + d0); const unsigned uu[4] = {uw.x, uw.y, uw.z, uw.w}; float a[8];
#pragma unroll
                        for (int e = 0; e < 8; ++e) { float s = bsj[j];
#pragma unroll
                            for (int k = 0; k < 4; ++k) s += wsj[j][k] * vn[k][e];
                            const float uv = (e & 1) ? bfhi(uu[e >> 1]) : bflo(uu[e >> 1]); a[e] = uv * s; }
#pragma unroll
                        for (int e = 0; e < 8; ++e) ssa[j] += a[e] * a[e];
                        { u32x4 w; w.x = pk2(a[0], a[1]); w.y = pk2(a[2], a[3]); w.z = pk2(a[4], a[5]); w.w = pk2(a[6], a[7]);
                            *(u32x4*)(AOUT + (size_t)(row0 + j) * 512 + h * 128 + d0) = w; } } }
#pragma unroll
                for (int j = 0; j < 4; ++j) { float s = ssa[j]; s += __shfl_xor(s, 1); s += __shfl_xor(s, 2); s += __shfl_xor(s, 4); s += __shfl_xor(s, 8); if ((tid & 15) == 0) SSQA[row0 + j] = s; }
            }
        }
    }
}

__device__ __forceinline__ void scan_phase(KP kp) {
    unsigned char* ws = p.ws; const float* EB = (const float*)(ws + W_EB); bf16_t* AG = (bf16_t*)(ws + W_AG);
    const float* A16 = (const float*)(ws + W_A16); const float* AM12 = (const float*)(ws + W_AM12);
    const int GT = gridDim.x * 512;
    for (int id = blockIdx.x * 512 + threadIdx.x; id < 16384 * 8; id += GT) {
        const int seg = id & 7, sid = id >> 3, b = sid >> 11, gp = sid & 2047, gg = gp >> 6, pp = gp & 63; const float ar = A16[gp], ai = A16[2048 + gp];
        const size_t rbase = (size_t)gg * MC16 + b * 128 + seg * 16;
        float er[16], ei[16];
#pragma unroll
        for (int k = 0; k < 16; ++k) { er[k] = EB[(rbase + k) * 128 + pp]; ei[k] = EB[(rbase + k) * 128 + 64 + pp]; }
        float hr = 0.f, hi = 0.f;
#pragma unroll
        for (int k = 0; k < 16; ++k) { const float nr = ar * hr - ai * hi + er[k], ni = ar * hi + ai * hr + ei[k]; hr = nr; hi = ni; }
        float mr = ar, mi = ai;
#pragma unroll
        for (int q = 0; q < 4; ++q) { const float nr = mr * mr - mi * mi, ni = 2.f * mr * mi; mr = nr; mi = ni; }
#pragma unroll
        for (int d = 1; d < 8; d <<= 1) {
            const float hpr = __shfl_up(hr, d, 8), hpi = __shfl_up(hi, d, 8), mpr = __shfl_up(mr, d, 8), mpi = __shfl_up(mi, d, 8);
            if (seg >= d) { const float nhr = hr + mr * hpr - mi * hpi, nhi = hi + mr * hpi + mi * hpr, nmr = mr * mpr - mi * mpi, nmi = mr * mpi + mi * mpr; hr = nhr; hi = nhi; mr = nmr; mi = nmi; } }
        float cr = __shfl_up(hr, 1, 8), ci = __shfl_up(hi, 1, 8); if (seg == 0) { cr = 0.f; ci = 0.f; }
#pragma unroll
        for (int k = 0; k < 16; ++k) { bf16_t* hp = AG + (rbase + k) * KY + 256 + pp; hp[0] = f2bf(cr); hp[64] = f2bf(ci);
            const float nr = ar * cr - ai * ci + er[k], ni = ar * ci + ai * cr + ei[k]; cr = nr; ci = ni; }
        if (seg == 7) { p.out[O_SRP + sid] = cr; p.out[O_SIP + sid] = ci; }
    }
    for (int id = 16384 + blockIdx.x * 512 + threadIdx.x; id < (8 + 128) * 2048; id += GT) {
        if (false) {
        } else { const int id2 = id - 16384, b = id2 >> 11, gp = id2 & 2047, gg = gp >> 6, pp = gp & 63;
            const float sr = p.st_re[id2], si = p.st_im[id2], qr = AM12[gp], qi = AM12[2048 + gp];
            const float hr = sr * qr - si * qi, hi = sr * qi + si * qr; const size_t row = (size_t)gg * MC16 + 1024 + b;
            bf16_t* hp = AG + row * KY + 256 + pp; hp[0] = f2bf(hr); hp[64] = f2bf(hi);
            const float ar = A16[gp], ai = A16[2048 + gp];
            p.out[O_SRS + id2] = ar * hr - ai * hi + EB[row * 128 + pp]; p.out[O_SIS + id2] = ar * hi + ai * hr + EB[row * 128 + 64 + pp]; }
    }
    { bf16_t* MIX = (bf16_t*)(ws + W_MIX); const bf16_t* AOUT = (const bf16_t*)(ws + W_AOUT); const float* SSQA = (const float*)(ws + W_SSQA);
      for (int i = blockIdx.x * 512 + threadIdx.x; i < MTOK * 64; i += GT) { const int r = i >> 6, c = (i & 63) * 8; const float ra = rsqrtf(SSQA[r] * (1.0f / 512.0f) + EPS);
          u32x4* mp = (u32x4*)(MIX + (size_t)r * 1024 + 512 + c); const u32x4 o = *(const u32x4*)(AOUT + (size_t)r * 512 + c); u32x4 w;
          w.x = pk2(bflo(o.x) * ra, bfhi(o.x) * ra); w.y = pk2(bflo(o.y) * ra, bfhi(o.y) * ra); w.z = pk2(bflo(o.z) * ra, bfhi(o.z) * ra); w.w = pk2(bflo(o.w) * ra, bfhi(o.w) * ra); *mp = w; } }
}

__device__ __forceinline__ void ld8bf(const bf16_t* q, float (&o)[8]) { const u32x4 w = *(const u32x4*)q; o[0] = bflo(w.x); o[1] = bfhi(w.x); o[2] = bflo(w.y); o[3] = bfhi(w.y); o[4] = bflo(w.z); o[5] = bfhi(w.z); o[6] = bflo(w.w); o[7] = bfhi(w.w); }
__device__ __forceinline__ void ld8f(const float* q, float (&o)[8]) { const f32x4 a = *(const f32x4*)q, b = *(const f32x4*)(q + 4); o[0] = a[0]; o[1] = a[1]; o[2] = a[2]; o[3] = a[3]; o[4] = b[0]; o[5] = b[1]; o[6] = b[2]; o[7] = b[3]; }
__device__ __forceinline__ void act_phase(KP kp) {
    unsigned char* ws = p.ws; bf16_t* ACT = (bf16_t*)(ws + W_ACT); const bf16_t* HALO = (const bf16_t*)(ws + W_HALO); const bf16_t* HEAD = (const bf16_t*)(ws + W_HEAD); const bf16_t* UPS = (const bf16_t*)(ws + W_UPS);
    const int GT = gridDim.x * 512, gt = blockIdx.x * 512 + threadIdx.x;
    const float* cw = p.conv_w; const float* cb = p.conv_b;
    for (int e = gt; e < (512 + 512) * 352; e += GT) {
        const int rowi = e / 352, col = (e % 352) * 8;
        float ga[8], va[8], t[8], w[8]; int orow;
        ld8f(cb + col, ga); ld8f(cb + FF + col, va);
        if (rowi < 512) { const int k = rowi >> 1, rr = rowi & 1; const bool hist = ((k * 64) & 2047) != 0; orow = k * 64 + rr;
#pragma unroll
            for (int q = 0; q < 3; ++q) { const int idx = rr + q - 2; const bf16_t* src = nullptr;
                if (idx >= 0) src = HEAD + (size_t)(k * 2 + idx) * FF2 + col; else if (hist) src = HALO + (size_t)((k - 1) * 2 + idx + 2) * FF2 + col;
                if (src) { ld8bf(src, t); ld8f(cw + q * FF2 + col, w);
#pragma unroll
                    for (int i = 0; i < 8; ++i) ga[i] += w[i] * t[i];
                    ld8bf(src + FF, t); ld8f(cw + q * FF2 + FF + col, w);
#pragma unroll
                    for (int i = 0; i < 8; ++i) va[i] += w[i] * t[i]; } } }
        else { const int rs = rowi - 512, b = rs >> 2, j = rs & 3; orow = MPR + rs;
#pragma unroll
            for (int q = 0; q < 3; ++q) { const int idx = j + q - 2;
                if (idx >= 0) { const bf16_t* src = UPS + (size_t)(b * 4 + idx) * FF2 + col; ld8bf(src, t); ld8f(cw + q * FF2 + col, w);
#pragma unroll
                    for (int i = 0; i < 8; ++i) ga[i] += w[i] * t[i];
                    ld8bf(src + FF, t); ld8f(cw + q * FF2 + FF + col, w);
#pragma unroll
                    for (int i = 0; i < 8; ++i) va[i] += w[i] * t[i]; }
                else { const float* src = p.st_conv + (size_t)(b * 2 + idx + 2) * FF2 + col; ld8f(src, t); ld8f(cw + q * FF2 + col, w);
#pragma unroll
                    for (int i = 0; i < 8; ++i) ga[i] += w[i] * t[i];
                    ld8f(src + FF, t); ld8f(cw + q * FF2 + FF + col, w);
#pragma unroll
                    for (int i = 0; i < 8; ++i) va[i] += w[i] * t[i]; } } }
        u32x4 o; o.x = pk2(gelu_t(ga[0]) * va[0], gelu_t(ga[1]) * va[1]); o.y = pk2(gelu_t(ga[2]) * va[2], gelu_t(ga[3]) * va[3]);
        o.z = pk2(gelu_t(ga[4]) * va[4], gelu_t(ga[5]) * va[5]); o.w = pk2(gelu_t(ga[6]) * va[6], gelu_t(ga[7]) * va[7]);
        *(u32x4*)(ACT + act_off(orow, col)) = o;
    }
}

__device__ __forceinline__ void final_phase(KP kp) {
    const float* ssq = (const float*)(p.ws + W_SSQF); const int GT = gridDim.x * 512;
    for (int i = blockIdx.x * 512 + threadIdx.x; i < MPR * 128; i += GT) { const int r = i >> 7, c = (i & 127) * 8;
        const float s = rsqrtf(ssq[r] * (1.0f / 1024.0f) + EPS); float* hp = p.out + (size_t)r * 1024 + c; const f32x4 g0 = *(const f32x4*)(p.g_final + c), g1 = *(const f32x4*)(p.g_final + c + 4);
        const u32x4 hw = *(const u32x4*)((const bf16_t*)(p.ws + W_HB) + (size_t)r * 1024 + c);
        __builtin_nontemporal_store((f32x4){bflo(hw.x), bfhi(hw.x), bflo(hw.y), bfhi(hw.y)} * s * g0, (f32x4*)hp); __builtin_nontemporal_store((f32x4){bflo(hw.z), bfhi(hw.z), bflo(hw.w), bfhi(hw.w)} * s * g1, (f32x4*)(hp + 4)); }
    const int lane = threadIdx.x & 63, wv = blockIdx.x * 8 + (threadIdx.x >> 6);
    const float* PART = (const float*)(p.ws + W_PART);
    for (int r = MPR + wv; r < MTOK; r += gridDim.x * 8) { f32x4* hp = (f32x4*)(p.out + (size_t)r * 1024); f32x4 v[4]; float sq = 0.f;
#pragma unroll
        for (int i = 0; i < 4; ++i) { v[i] = (f32x4){0.f, 0.f, 0.f, 0.f};
            for (int kc = 0; kc < 11; ++kc) v[i] += ((const f32x4*)(PART + ((size_t)kc * 512 + (r - MPR)) * 1024))[lane + i * 64];
            sq += v[i][0] * v[i][0] + v[i][1] * v[i][1] + v[i][2] * v[i][2] + v[i][3] * v[i][3]; }
#pragma unroll
        for (int o = 32; o >= 1; o >>= 1) sq += __shfl_xor(sq, o);
        const float s = rsqrtf(sq * (1.0f / 1024.0f) + EPS);
#pragma unroll
        for (int i = 0; i < 4; ++i) hp[lane + i * 64] = v[i] * s * ((const f32x4*)p.g_final)[lane + i * 64]; }
}

__global__ void __launch_bounds__(512, 2) fwd_kernel(Params p_unused) {
    extern __shared__ __attribute__((aligned(16))) unsigned char shm[];
    KP kp = (KP)__builtin_amdgcn_kernarg_segment_ptr();
    LAS unsigned char* lds = (LAS unsigned char*)shm;
    cg::grid_group grid = cg::this_grid();
    unsigned char* ws = p.ws; const int G = gridDim.x, bid = blockIdx.x;
    const int lo = p.ph_lo, hi = p.ph_hi;
    if (threadIdx.x < 2) ((volatile LAS unsigned*)(lds + 131072))[threadIdx.x] = 0u;
    __syncthreads();
    if (threadIdx.x == 0) (void)xb_add(&((unsigned*)(p.ws + W_BAR))[XB_XCNT(xb_xcc_id())], 1u);
    if (lo < 0) grid.sync();
    const int cid = bid;
#ifndef PHMASK
#define PHMASK 0x7ff
#endif
#define IN(k) (((PHMASK >> (k)) & 1) && lo <= (k) && (k) < hi)
#define GSYNC() xcd_barrier((unsigned*)(p.ws + W_BAR), (volatile LAS unsigned*)(lds + 131072))
#define SYNC(k) do { if (IN(k) && IN((k) + 1)) GSYNC(); } while (0)
    if (IN(0)) { phase0(kp, lds); } SYNC(0);
    if (IN(1)) { pg8::Gemm g = pg8::gemm_rm((const bf16_t*)(ws + W_XB), (const bf16_t*)(ws + W_WIN), 1024, 1024); pg8::StaticOrder S; S.init(MTOK, NPROJ, 1024, G, cid);
        EpiProj E{(const float*)(ws + W_R1), (bf16_t*)(ws + W_U), (bf16_t*)(ws + W_V), (bf16_t*)(ws + W_AG)};
        pg8::gemm_phase(lds, g, S, E, pg8::NoMid{});
        if (cid >= G - 64) { __syncthreads(); ssm_prep(kp, (cid - (G - 64)) >> 1, (cid - (G - 64)) & 1, (LAS float*)lds, threadIdx.x); }
        else if (cid >= 140) tr_range(kp, lds, 1056, 1408, cid - 140, G - 64 - 140); } SYNC(1);
    if (IN(2)) { { pg8::Gemm g = pg8::gemm_rm((const bf16_t*)(ws + W_AG), (const bf16_t*)(ws + W_WE), KY, 256); pg8::BatchedOrder S{160, 5, G, bid, 4}; EpiE E{(float*)(ws + W_EB)};
          pg8::gemm_phase(lds, g, S, E, pg8::NoMid{}); }
        __syncthreads();
        sgu_phase(kp, lds, 160); } SYNC(2);
    if (IN(3)) { scan_phase(kp); tr_range(kp, lds, 192, 352, bid, G); } SYNC(3);
    if (IN(4)) { pg8::Gemm g = pg8::gemm_rm((const bf16_t*)(ws + W_AG), (const bf16_t*)(ws + W_WY), KY, KY); pg8::BatchedOrder S{160, 5, G, bid, 6};
        EpiY E{(const bf16_t*)(ws + W_AG), p.d_skip, (bf16_t*)(ws + W_GB)};
        pg8::gemm_phase(lds, g, S, E, pg8::NoMid{});
        if (bid >= 160) tr_range(kp, lds, 352, 1056, bid - 160, G - 160); } SYNC(4);
    if (IN(5)) { pg8::Gemm g = pg8::gemm_rm((const bf16_t*)(ws + W_GB), (const bf16_t*)(ws + W_WGLU), 512, 512); pg8::StaticOrder S; S.init(MTOK, 512, 512, G, cid);
        EpiGlu E{(const bf16_t*)(ws + W_GB), p.b_glu, (bf16_t*)(ws + W_MIX), (float*)(ws + W_SSQB)};
        pg8::gemm_phase(lds, g, S, E, pg8::NoMid{}); } SYNC(5);
    if (IN(6)) { pg8::Gemm g = pg8::gemm_rm((const bf16_t*)(ws + W_MIX), (const bf16_t*)(ws + W_WOUT), 1024, 1024); pg8::SplitOrder S; S.init(MPR, 1024, 1024, G, cid);
        EpiOut E{p.x_prompt, p.x_sample, p.out, (bf16_t*)(ws + W_HB), (float*)(ws + W_SSQH), (const float*)(ws + W_SSQB), (float*)(ws + W_PART), (const bf16_t*)(ws + W_XB)}; MidOut MD{(const float*)(ws + W_SSQB)};
        pg8::gemm_phase(lds, g, S, E, MD);
        GSYNC();
        {
            const int lane = threadIdx.x & 63; const float* PART = (const float*)(ws + W_PART); bf16_t* HB = (bf16_t*)(ws + W_HB); float* SSQH = (float*)(ws + W_SSQH);
            for (int rs = bid * 8 + (threadIdx.x >> 6); rs < 512; rs += G * 8) { float sq = 0.f;
#pragma unroll
                for (int i = 0; i < 4; ++i) { f32x4 v = ((const f32x4*)(p.x_sample + (size_t)rs * 1024))[lane + i * 64];
#pragma unroll
                    for (int kc = 0; kc < 4; ++kc) v += ((const f32x4*)(PART + ((size_t)kc * 512 + rs) * 1024))[lane + i * 64];
                    sq += v[0] * v[0] + v[1] * v[1] + v[2] * v[2] + v[3] * v[3];
                    u32x2 w; w.x = pk2(v[0], v[1]); w.y = pk2(v[2], v[3]); ((u32x2*)(HB + (size_t)(MPR + rs) * 1024))[lane + i * 64] = w; }
#pragma unroll
                for (int o = 32; o >= 1; o >>= 1) sq += __shfl_xor(sq, o);
                if (lane == 0) SSQH[MPR + rs] = sq; } } } SYNC(6);
    if (IN(7)) { pg8::Gemm g = pg8::gemm_rm((const bf16_t*)(ws + W_HB), (const bf16_t*)(ws + W_WUP), 1024, 1024); pg8::StaticOrder S; S.init(MTOK, FF2, 1024, G, cid);
        EpiUp E{(const float*)(ws + W_SSQH), (bf16_t*)(ws + W_ACT), (bf16_t*)(ws + W_HALO), (bf16_t*)(ws + W_HEAD), (bf16_t*)(ws + W_UPS), p.out, p.conv_w, p.conv_b};
        pg8::gemm_phase(lds, g, S, E, pg8::NoMid{}); } SYNC(7);
    if (IN(8)) { act_phase(kp); } SYNC(8);
    if (IN(9)) { pg8::Gemm g{(const bf16_t*)(ws + W_ACT), (const bf16_t*)(ws + W_WDN), 64, 64, 32768, 32768, (size_t)32768 * (FF / 64), (size_t)32768 * (FF / 64)}; pg8::SplitOrder S; S.init(MPR, 1024, FF, G, cid);
        EpiDown E{p.out, (float*)(ws + W_SSQF), (const bf16_t*)(ws + W_HB), (float*)(ws + W_PART), (bf16_t*)(ws + W_HB)};
        pg8::gemm_phase(lds, g, S, E, pg8::NoMid{}); } SYNC(9);
    if (IN(10)) { final_phase(kp); }
#ifdef DUMP_OFF
    { GSYNC();
      const bf16_t* src = (const bf16_t*)(ws + (DUMP_OFF)); for (size_t i = (size_t)bid * 512 + threadIdx.x; i < (size_t)(DUMP_N); i += (size_t)G * 512) p.out[i] = __uint_as_float((unsigned)src[i] << 16); }
#endif
#ifdef DUMPF_OFF
    { GSYNC();
      const float* src = (const float*)(ws + (DUMPF_OFF)); for (size_t i = (size_t)bid * 512 + threadIdx.x; i < (size_t)(DUMPF_N); i += (size_t)G * 512) p.out[i] = src[i]; }
#endif
#undef IN
#undef SYNC
#undef p
}

extern "C" void kernel_launch(void* const* d_in, const int* in_sizes, int n_in, void* d_out, int out_size, void* d_ws, size_t ws_size, hipStream_t stream) {
    static int grid = 0;
    if (grid == 0) {
        if (n_in != 29 || ws_size < W_END) { fprintf(stderr, "kernel_launch: unexpected n_in %d / ws_size %zu (need %zu)\n", n_in, ws_size, (size_t)W_END); grid = -1; return; }
        int dev = 0, cus = 0, per_cu = 0;
        hipGetDevice(&dev); hipDeviceGetAttribute(&cus, hipDeviceAttributeMultiprocessorCount, dev);
        if (hipFuncSetAttribute((const void*)fwd_kernel, hipFuncAttributeMaxDynamicSharedMemorySize, LDS_BYTES) != hipSuccess) { fprintf(stderr, "kernel_launch: hipFuncSetAttribute failed\n"); (void)hipGetLastError(); }
        if (hipOccupancyMaxActiveBlocksPerMultiprocessor(&per_cu, (const void*)fwd_kernel, 512, LDS_BYTES) != hipSuccess || per_cu < 1) { per_cu = 1; (void)hipGetLastError(); }
        if (per_cu > 1) per_cu = 1;
        grid = cus * per_cu;
        if (grid > 256) grid = 256;
    }
    if (grid < 0) return;
    Params p{};
    const float** pp = (const float**)&p;
    for (int i = 0; i < 29; ++i) pp[i] = (const float*)d_in[i];
    p.out = (float*)d_out; p.ws = (unsigned char*)d_ws; p.ph_lo = 0; p.ph_hi = PH_HI;
    (void)hipMemsetAsync((unsigned char*)d_ws + W_BAR, 0, XCD_BAR_WORDS * 4, stream);
    void* args[] = {&p};
    hipError_t e = hipLaunchCooperativeKernel((const void*)fwd_kernel, dim3(grid), dim3(512), args, LDS_BYTES, stream);
    if (e != hipSuccess) fprintf(stderr, "cooperative launch failed: %s (grid %d)\n", hipGetErrorString(e), grid);
}
```

```cpp
#include <hip/hip_runtime.h>
#include <hip/hip_cooperative_groups.h>
#include <cstdio>
#define PH_HI 11
namespace cg = cooperative_groups;

#define LAS __attribute__((address_space(3)))
typedef unsigned short bf16_t;
typedef short bf16x8 __attribute__((ext_vector_type(8)));
typedef float f32x4 __attribute__((ext_vector_type(4)));
typedef unsigned u32x4 __attribute__((ext_vector_type(4)));
typedef unsigned u32x2 __attribute__((ext_vector_type(2)));

constexpr int MTOK = 16896, MPR = 16384, DM = 1024, NPROJ = 1536, FF = 2816, FF2 = 5632;
constexpr int MC16 = 1280, KY = 384;
constexpr float EPS = 1e-6f;
constexpr size_t O_Y = 0, O_VS = 17301504, O_SRP = 17563648, O_SIP = 17580032, O_CP = 17596416, O_SRS = 17686528, O_SIS = 17948672, O_CS = 18210816;
constexpr size_t W_WUP = 0, W_WDN = 11534336, W_HB = 17301504, W_HALO = 51904512, W_UPS = 57851904, W_SSQB = 63619072, W_SSQH = 63686656,
                 W_SSQF = 63754240, W_R1 = 63821824, W_A16 = 63889408, W_AM12 = 63905792, W_SSQA = 63922176, W_BAR = 63989760, W_UP = 64006144;
constexpr size_t W_WIN = W_UP + 0, W_WGLU = W_UP + 3145728, W_WOUT = W_UP + 3670016, W_WTRIL = W_UP + 5767168, W_WY = W_UP + 5898240,
                 W_WE = W_UP + 12189696, W_XB = W_UP + 16384000, W_GB = W_UP + 50987008  , W_U = W_UP + 50987008, W_V = W_UP + 68288512,
                 W_AG = W_UP + 85590016, W_EB = W_UP + 117047296, W_MIX = W_UP + 138018816, W_AOUT = W_UP + 172621824;
constexpr size_t W_ACT = W_UP, W_HEAD = W_UP + 100663296, W_PART = W_UP + 110100480;
constexpr size_t W_END = W_UP + (size_t)MTOK * FF2 * 2;
constexpr int LDS_BYTES = 131072 + 16;

struct Params {
    const float *x_prompt, *x_sample, *st_re, *st_im, *st_conv, *g_mix, *w_in, *g_v, *w_s, *b_s, *lam_re, *lam_im, *log_dt, *b_re, *b_im, *c_re, *c_im,
        *d_skip, *w_glu, *b_glu, *g_out_a, *g_out_b, *w_out, *g_ffn, *w_ffn_in, *conv_w, *conv_b, *w_ffn_out, *g_final;
    float* out; unsigned char* ws; int ph_lo, ph_hi;
};
typedef const __attribute__((address_space(4))) Params* KP;
#define p (*kp)

__device__ __forceinline__ unsigned short f2bf(float f) { unsigned u = __float_as_uint(f); u += 0x7FFFu + ((u >> 16) & 1u); return (unsigned short)(u >> 16); }
__device__ __forceinline__ float bflo(unsigned w) { return __uint_as_float(w << 16); }
__device__ __forceinline__ float bfhi(unsigned w) { return __uint_as_float(w & 0xffff0000u); }
__device__ __forceinline__ unsigned pk2(float lo, float hi) { return (unsigned)f2bf(lo) | ((unsigned)f2bf(hi) << 16); }
__device__ __forceinline__ float gelu_t(float x) { const float z = -2.3022082f * (x + 0.044715f * x * x * x); return x * __builtin_amdgcn_rcpf(1.0f + __builtin_amdgcn_exp2f(z)); }
__device__ __forceinline__ float sigm(float x) { return __builtin_amdgcn_rcpf(1.0f + __builtin_amdgcn_exp2f(-1.44269504f * x)); }
template <int CTRL> __device__ __forceinline__ float dpps(float old, float v) { return __int_as_float(__builtin_amdgcn_update_dpp(__float_as_int(old), __float_as_int(v), CTRL, 0xf, 0xf, false)); }
template <int CTRL> __device__ __forceinline__ float dppf(float v) { return __int_as_float(__builtin_amdgcn_update_dpp(0, __float_as_int(v), CTRL, 0xf, 0xf, false)); }


#define XB_TMO      128
#define XB_XCNT(j)  (256  + 64 * (j))
#define XB_XSUB(j)  (1280 + 64 * (j))
#define XB_XGEN(j)  (2304 + 64 * (j))
#define XB_TOP      3328
#define XB_TOPGEN   3392
#define XCD_BAR_WORDS 3456
#define XB_SPIN_CAP (1u << 18)
__device__ __forceinline__ unsigned xb_ld(unsigned* q)              { return __hip_atomic_load(q, __ATOMIC_RELAXED, __HIP_MEMORY_SCOPE_AGENT); }
__device__ __forceinline__ unsigned xb_add(unsigned* q, unsigned v) { return __hip_atomic_fetch_add(q, v, __ATOMIC_RELAXED, __HIP_MEMORY_SCOPE_AGENT); }
__device__ __forceinline__ unsigned xb_xcc_id() { return (unsigned)__builtin_amdgcn_s_getreg((3 << 11) | 20) & 0xFu; }
#define XB_SPIN(cond, bar) do { unsigned _sp = 0; while (cond) { __builtin_amdgcn_s_sleep(1); \
    if ((++_sp & 255u) == 0u) { if (xb_ld(&(bar)[XB_TMO])) break; if (_sp > XB_SPIN_CAP) { atomicAdd(&(bar)[XB_TMO], 1u); break; } } } } while (0)
__device__ __forceinline__ void xcd_barrier_complete(unsigned* bar, unsigned x, unsigned& nloc, unsigned& nx) {
    const unsigned G = gridDim.x;
    unsigned sum, cnt, mine, sp = 0u;
    for (;;) {
        sum = 0u; cnt = 0u; mine = 0u;
#pragma unroll
        for (unsigned j = 0; j < 16; ++j) { const unsigned c = xb_ld(&bar[XB_XCNT(j)]); sum += c; cnt += (c > 0u) ? 1u : 0u; mine = (j == x) ? c : mine; }
        if (sum == G) break;
        __builtin_amdgcn_s_sleep(1);
        if ((++sp & 255u) == 0u) { if (xb_ld(&bar[XB_TMO])) break; if (sp > XB_SPIN_CAP) { atomicAdd(&bar[XB_TMO], 1u); break; } }
    }
    nloc = mine > 0u ? mine : 1u; nx = cnt > 0u ? cnt : 1u;
}
__device__ __forceinline__ void xcd_barrier(unsigned* bar, volatile LAS unsigned* st) {
    asm volatile("s_waitcnt vmcnt(0)" ::: "memory");
    __syncthreads();
    if (threadIdx.x == 0) {
        __builtin_amdgcn_s_waitcnt(0);
        const unsigned x = xb_xcc_id();
        unsigned nloc = st[0], nx = st[1];
        if (nloc == 0u) { xcd_barrier_complete(bar, x, nloc, nx); st[0] = nloc; st[1] = nx; }
        const unsigned old = xb_add(&bar[XB_XSUB(x)], 1u);
        const unsigned gen = old / nloc;
        if (old + 1u == (gen + 1u) * nloc) {
            __builtin_amdgcn_fence(__ATOMIC_RELEASE, "agent");
            asm volatile("s_waitcnt vmcnt(0)" ::: "memory");
            const unsigned og = xb_add(&bar[XB_TOP], 1u);
            const unsigned tg = og / nx;
            if (og + 1u == (tg + 1u) * nx) xb_add(&bar[XB_TOPGEN], 1u);
            else XB_SPIN(xb_ld(&bar[XB_TOPGEN]) == tg, bar);
            __builtin_amdgcn_fence(__ATOMIC_ACQUIRE, "agent");
            xb_add(&bar[XB_XGEN(x)], 1u);
            asm volatile("s_waitcnt vmcnt(0)" ::: "memory");
        } else {
            XB_SPIN(xb_ld(&bar[XB_XGEN(x)]) == gen, bar);
            __builtin_amdgcn_fence(__ATOMIC_ACQUIRE, "agent");
            asm volatile("s_waitcnt vmcnt(0)" ::: "memory");
        }
    }
    __syncthreads();
}

namespace pg8 {
constexpr int BM = 256, BK = 64, HALF = 128, HTB = HALF * BK * 2, STAGE_BYTES = 8 * HTB, NXCD = 8, WGM = 8;
__device__ __forceinline__ int lds_byte(int r, int c) { const int st = (r >> 4) * 2 + (c >> 5), rr = r & 15, cc = c & 31, ob = rr * 64 + cc * 2; return st * 1024 + (ob ^ (((ob >> 9) & 1) << 5)); }
__device__ __forceinline__ void stage_rc(int b, int& R, int& C) { const int st = b / 1024, sb = b % 1024, swz = sb ^ (((sb >> 9) & 1) << 5); R = (st >> 1) * 16 + swz / 64; C = (st & 1) * 32 + (swz % 64) / 2; }
__device__ __forceinline__ int perm32(int rho) { const int n = rho >> 4, i = rho & 15; return 8 * (i >> 2) + 4 * n + (i & 3); }
struct Unit { int pm, pn, k0, nt; };
struct Gemm { const bf16_t* A; const bf16_t* Bt; int lda, ldb; size_t kstepA, kstepB, tstepA, tstepB; };
__device__ __forceinline__ Gemm gemm_rm(const bf16_t* A, const bf16_t* Bt, int lda, int ldb) { return Gemm{A, Bt, lda, ldb, 128, 128, (size_t)512 * lda, (size_t)512 * ldb}; }
struct StaticOrder {
    int nM, nN, nwg, G, c, ntK;
    __device__ void init(int M, int N, int K, int G_, int c_) { nM = M / BM; nN = N / BM; nwg = nM * nN; G = G_; c = c_; ntK = K / BK; }
    __device__ bool next(int i, Unit& u) const {
        const long L = (long)i * G + c; if (L >= nwg) return false;
        int wgid = (int)L; { const int q = nwg / NXCD, r = nwg % NXCD, xcd = wgid % NXCD, off = wgid / NXCD; wgid = (xcd < r ? xcd * (q + 1) : r * (q + 1) + (xcd - r) * q) + off; }
        const int nig = WGM * nN, gid = wgid / nig, fm = gid * WGM, gsz = (nM - fm) < WGM ? (nM - fm) : WGM;
        u.pm = fm + ((wgid % nig) % gsz); u.pn = (wgid % nig) / gsz; u.k0 = 0; u.nt = ntK; return true;
    }
};
struct BatchedOrder {
    int nu, per, G, c, ntK;
    __device__ bool next(int i, Unit& u) const { int L = i * G + c; if (L >= nu) return false;
        if (G == 256 && nu == 160 && per == 5) { const int x = c & 7, slot = c >> 3; L = (4 * x + slot / 5) * 5 + slot % 5; }
        u.pm = L; u.pn = L / per; u.k0 = 0; u.nt = ntK; return true; }
};
struct SplitOrder {
    StaticOrder S0; int nN, nch, pm0;
    __device__ void init(int Mmain, int N, int K, int G_, int c_) { S0.init(Mmain, N, K, G_, c_); nN = N / BM; nch = K / 256; pm0 = Mmain / BM; }
    __device__ bool next(int i, Unit& u) const {
        if (S0.next(i, u)) return true;
        const int R = ((S0.nwg + S0.G - 1) / S0.G) * S0.G, s = i * S0.G + S0.c - R;
        if (s < 0 || s >= 2 * nN * nch) return false;
        u.pm = pm0 + s / (nN * nch); u.pn = (s / nch) % nN; u.k0 = (s % nch) * 256; u.nt = 4; return true;
    }
};
__device__ __forceinline__ unsigned cvt_pk_bf16(float lo, float hi) { unsigned r; asm volatile("v_cvt_pk_bf16_f32 %0, %1, %2" : "=v"(r) : "v"(lo), "v"(hi)); return r; }
struct NoMid { static constexpr bool ON = false; __device__ __forceinline__ void operator()(f32x4 (&)[2][2][4][2], const Unit&, int, int) const {} };

template <class Epi, class Sched, class Mid>
__device__ __forceinline__ void gemm_phase(LAS unsigned char* lds, const Gemm g, const Sched& S, const Epi& E, const Mid& MD) {
    const int tid = threadIdx.x, wid = __builtin_amdgcn_readfirstlane(tid >> 6), lane = tid & 63, wr = wid >> 2, wc = wid & 3, fr = lane & 15, fq = lane >> 4;
    unsigned voffA[2], voffB[2];
#pragma unroll
    for (int i = 0; i < 2; ++i) { int R, C; stage_rc(tid * 16 + i * 8192, R, C); const int Rb = Epi::PERM ? ((R & ~31) + perm32(R & 31)) : R;
        voffA[i] = (unsigned)(R * g.lda + C) * 2u; voffB[i] = (unsigned)(Rb * g.ldb + C) * 2u; }
    const size_t kstepA = g.kstepA, kstepB = g.kstepB;
    const size_t hstepA = (size_t)HALF * g.lda * 2, hstepB = (size_t)HALF * g.ldb * 2;
    const size_t tstepA = g.tstepA, tstepB = g.tstepB;
    const unsigned ldsw = (unsigned)wid * 1024u;
    const int aoff = lds_byte(wr * 64 + fr, fq * 8), boff = lds_byte(wc * 32 + fr, fq * 8);
#define PG8_SA(b, h) (((b) * 2 + (h)) * HTB)
#define PG8_SB(b, h) ((4 + (b) * 2 + (h)) * HTB)
#define PG8_STAGE(bufoff, gbase, voff) do { _Pragma("unroll") for (int _i = 0; _i < 2; ++_i) \
        __builtin_amdgcn_global_load_lds((const unsigned*)((const char*)(gbase) + (voff)[_i]), (LAS unsigned*)(lds + (bufoff) + ldsw + _i * 8192), 16, 0, 0); } while (0)
#define PG8_LDA(dst, b, h) do { _Pragma("unroll") for (int m = 0; m < 4; ++m) _Pragma("unroll") for (int k = 0; k < 2; ++k) dst[m][k] = *(const LAS bf16x8*)(lds + PG8_SA(b, h) + aoff + m * 2048 + k * 1024); } while (0)
#define PG8_LDB(dst, b, h) do { _Pragma("unroll") for (int n = 0; n < 2; ++n) _Pragma("unroll") for (int k = 0; k < 2; ++k) dst[n][k] = *(const LAS bf16x8*)(lds + PG8_SB(b, h) + boff + n * 2048 + k * 1024); } while (0)
#define PG8_MMA(ai, bj, At, Bt) do { __builtin_amdgcn_s_setprio(1); _Pragma("unroll") for (int m = 0; m < 4; ++m) _Pragma("unroll") for (int n = 0; n < 2; ++n) _Pragma("unroll") for (int k = 0; k < 2; ++k) \
        acc[ai][bj][m][n] = __builtin_amdgcn_mfma_f32_16x16x32_bf16(Bt[n][k], At[m][k], acc[ai][bj][m][n], 0, 0, 0); __builtin_amdgcn_s_setprio(0); } while (0)
#define PG8_WAIT_V(n) asm volatile("s_waitcnt vmcnt(" #n ")" ::: "memory")
#define PG8_WAIT_L(n) asm volatile("s_waitcnt lgkmcnt(" #n ")" ::: "memory")
#define PG8_BAR __builtin_amdgcn_s_barrier()
#define PG8_SCHED __builtin_amdgcn_sched_barrier(0)
    Unit cur, nxt; int ui = 0;
    if (!S.next(0, cur)) return;
    f32x4 acc[2][2][4][2];
#pragma unroll
    for (int a = 0; a < 2; ++a)
#pragma unroll
        for (int b = 0; b < 2; ++b)
#pragma unroll
            for (int m = 0; m < 4; ++m)
#pragma unroll
                for (int n = 0; n < 2; ++n) acc[a][b][m][n] = (f32x4){0.f, 0.f, 0.f, 0.f};
    bf16x8 At[4][2], B0[2][2], B1[2][2];
    const char* cA = (const char*)g.A + (size_t)cur.pm * tstepA + (size_t)(cur.k0 >> 6) * kstepA; const char* cB = (const char*)g.Bt + (size_t)cur.pn * tstepB + (size_t)(cur.k0 >> 6) * kstepB;
    PG8_STAGE(PG8_SB(0, 0), cB, voffB); PG8_STAGE(PG8_SA(0, 0), cA, voffA); PG8_STAGE(PG8_SB(0, 1), cB + hstepB, voffB); PG8_STAGE(PG8_SA(0, 1), cA + hstepA, voffA);
    if (wr == 1) PG8_BAR;
    PG8_WAIT_V(4); PG8_BAR;
    PG8_STAGE(PG8_SB(1, 0), cB + kstepB, voffB); PG8_STAGE(PG8_SA(1, 0), cA + kstepA, voffA); PG8_STAGE(PG8_SB(1, 1), cB + hstepB + kstepB, voffB);
    PG8_WAIT_V(6); PG8_BAR;
    for (;;) {
        const bool has_next = S.next(ui + 1, nxt);
        const char* nA = has_next ? (const char*)g.A + (size_t)nxt.pm * tstepA + (size_t)(nxt.k0 >> 6) * kstepA : cA; const char* nB = has_next ? (const char*)g.Bt + (size_t)nxt.pn * tstepB + (size_t)(nxt.k0 >> 6) * kstepB : cB;
        const int nt = cur.nt;
        for (int t = 0; t < nt; t += 2) {
            const bool last = (t == nt - 2);
            if constexpr (Mid::ON) { if (t == (nt >> 1)) MD(acc, cur, wr, fr); }
            const char* a1 = cA + (size_t)(t + 1) * kstepA;
            const char* a2 = last ? nA : cA + (size_t)(t + 2) * kstepA; const char* b2 = last ? nB : cB + (size_t)(t + 2) * kstepB;
            const char* a3 = a2 + kstepA; const char* b3 = b2 + kstepB;
            PG8_LDB(B0, 0, 0); PG8_SCHED; PG8_LDA(At, 0, 0); PG8_STAGE(PG8_SA(1, 1), a1 + hstepA, voffA);
            PG8_WAIT_L(8); PG8_BAR; PG8_WAIT_L(0); PG8_MMA(0, 0, At, B0); PG8_BAR; PG8_SCHED;
            PG8_LDB(B1, 0, 1); PG8_STAGE(PG8_SB(0, 0), b2, voffB);
            PG8_BAR; PG8_WAIT_L(0); PG8_MMA(0, 1, At, B1); PG8_BAR;
            PG8_LDA(At, 0, 1); PG8_STAGE(PG8_SA(0, 0), a2, voffA);
            PG8_BAR; PG8_WAIT_L(0); PG8_MMA(1, 0, At, B0); PG8_BAR; PG8_SCHED;
            PG8_STAGE(PG8_SB(0, 1), b2 + hstepB, voffB);
            PG8_WAIT_V(6); PG8_BAR; PG8_MMA(1, 1, At, B1); PG8_BAR;
            PG8_LDB(B0, 1, 0); PG8_SCHED; PG8_LDA(At, 1, 0); PG8_STAGE(PG8_SA(0, 1), a2 + hstepA, voffA);
            PG8_WAIT_L(8); PG8_BAR; PG8_WAIT_L(0); PG8_MMA(0, 0, At, B0); PG8_BAR; PG8_SCHED;
            PG8_LDB(B1, 1, 1); PG8_STAGE(PG8_SB(1, 0), b3, voffB);
            PG8_BAR; PG8_WAIT_L(0); PG8_MMA(0, 1, At, B1); PG8_BAR;
            PG8_LDA(At, 1, 1); PG8_STAGE(PG8_SA(1, 0), a3, voffA);
            PG8_BAR; PG8_WAIT_L(0); PG8_MMA(1, 0, At, B0); PG8_BAR; PG8_SCHED;
            PG8_STAGE(PG8_SB(1, 1), b3 + hstepB, voffB);
            PG8_WAIT_V(6); PG8_BAR; PG8_MMA(1, 1, At, B1); PG8_BAR;
        }
        E(acc, cur, wr, wc, fr, fq);
        if (!has_next) break;
#pragma unroll
        for (int a = 0; a < 2; ++a)
#pragma unroll
            for (int b = 0; b < 2; ++b)
#pragma unroll
                for (int m = 0; m < 4; ++m)
#pragma unroll
                    for (int n = 0; n < 2; ++n) acc[a][b][m][n] = (f32x4){0.f, 0.f, 0.f, 0.f};
        cur = nxt; cA = nA; cB = nB; ++ui;
    }
    PG8_WAIT_V(0);
    if (wr == 0) PG8_BAR;
    PG8_BAR;
#undef PG8_SA
#undef PG8_SB
#undef PG8_STAGE
#undef PG8_LDA
#undef PG8_LDB
#undef PG8_MMA
#undef PG8_WAIT_V
#undef PG8_WAIT_L
#undef PG8_BAR
#undef PG8_SCHED
}
}
using pg8::Unit;
typedef f32x4 Acc[2][2][4][2];
__device__ __forceinline__ size_t act_off(int r, int j) { return ((size_t)((r >> 8) * (FF / 64) + (j >> 6)) * 256 + (r & 255)) * 64 + (j & 63); }

struct EpiProj { static constexpr bool PERM = true; const float* r1; bf16_t* U; bf16_t* V; bf16_t* AG;
    __device__ __forceinline__ void operator()(const Acc& acc, const Unit& u, int wr, int wc, int fr, int fq) const {
        const int row0 = u.pm * 256 + wr * 64 + fr, colt = u.pn * 256 + wc * 32 + 8 * fq;
#pragma unroll
        for (int ai = 0; ai < 2; ++ai)
#pragma unroll
            for (int m = 0; m < 4; ++m) { const int r = row0 + ai * 128 + m * 16; const float s = r1[r];
#pragma unroll
                for (int bj = 0; bj < 2; ++bj) { const int c = colt + bj * 128; const f32x4 v0 = acc[ai][bj][m][0] * s, v1 = acc[ai][bj][m][1] * s;
                    u32x4 w; w.x = pg8::cvt_pk_bf16(v0[0], v0[1]); w.y = pg8::cvt_pk_bf16(v0[2], v0[3]); w.z = pg8::cvt_pk_bf16(v1[0], v1[1]); w.w = pg8::cvt_pk_bf16(v1[2], v1[3]);
                    bf16_t* dst;
                    if (u.pn < 2) dst = U + (size_t)r * 512 + c;
                    else if (u.pn < 4) dst = V + (size_t)r * 512 + (c - 512);
                    else { const int ch = c - 1024, gg = ch >> 4, ci0 = ch & 15; int c16, t; if (r < MPR) { c16 = r >> 4; t = r & 15; } else { c16 = 1024 + ((r - MPR) >> 2); t = 12 + (r & 3); }
                        dst = AG + ((size_t)(gg * MC16 + c16) * KY + t * 16 + ci0); }
                    *(u32x4*)dst = w; } }
    }
};
struct EpiE { static constexpr bool PERM = false; float* EB;
    __device__ __forceinline__ void operator()(const Acc& acc, const Unit& u, int wr, int wc, int fr, int fq) const {
        const int row0 = u.pm * 256 + wr * 64 + fr, col0 = wc * 32 + 4 * fq;
#pragma unroll
        for (int ai = 0; ai < 2; ++ai)
#pragma unroll
            for (int m = 0; m < 4; ++m) { float* rp = EB + (size_t)(row0 + ai * 128 + m * 16) * 128 + col0;
#pragma unroll
                for (int n = 0; n < 2; ++n) *(f32x4*)(rp + n * 16) = acc[ai][0][m][n]; }
    }
};
struct EpiY { static constexpr bool PERM = true; const bf16_t* AG; const float* dsk; bf16_t* GB;
    __device__ __forceinline__ void operator()(const Acc& acc, const Unit& u, int wr, int wc, int fr, int fq) const {
        asm volatile("" : "+v"(fr), "+v"(fq));
        const int gg = u.pn, row0 = u.pm * 256 + wr * 64 + fr, colt = wc * 32 + 8 * fq;
#pragma unroll
        for (int ai = 0; ai < 2; ++ai)
#pragma unroll
            for (int m = 0; m < 4; ++m) { const int r = row0 + ai * 128 + m * 16, c16 = r - gg * MC16;
#pragma unroll
                for (int bj = 0; bj < 2; ++bj) { const int cb = colt + bj * 128, t = cb >> 4, co0 = cb & 15;
                    int tok = -1; if (c16 < 1024) tok = c16 * 16 + t; else if (c16 < 1152 && t >= 12) tok = MPR + (c16 - 1024) * 4 + (t - 12);
                    if (tok >= 0) {
                        const u32x4 xw = *(const u32x4*)(AG + (size_t)r * KY + cb);
                        u32x4 w;
                        { const f32x4 d0 = *(const f32x4*)(dsk + gg * 16 + co0); const f32x4 a0 = acc[ai][bj][m][0];
                          w.x = pg8::cvt_pk_bf16(gelu_t(a0[0] + d0[0] * bflo(xw.x)), gelu_t(a0[1] + d0[1] * bfhi(xw.x))); w.y = pg8::cvt_pk_bf16(gelu_t(a0[2] + d0[2] * bflo(xw.y)), gelu_t(a0[3] + d0[3] * bfhi(xw.y))); }
                        { const f32x4 d1 = *(const f32x4*)(dsk + gg * 16 + co0 + 4); const f32x4 a1 = acc[ai][bj][m][1];
                          w.z = pg8::cvt_pk_bf16(gelu_t(a1[0] + d1[0] * bflo(xw.z)), gelu_t(a1[1] + d1[1] * bfhi(xw.z))); w.w = pg8::cvt_pk_bf16(gelu_t(a1[2] + d1[2] * bflo(xw.w)), gelu_t(a1[3] + d1[3] * bfhi(xw.w))); }
                        *(u32x4*)(GB + (size_t)tok * 512 + gg * 16 + co0) = w; } }
                asm volatile("" ::: "memory"); }
    }
};
struct EpiGlu { static constexpr bool PERM = true; const bf16_t* GB; const float* bglu; bf16_t* MIX; float* ssq;
    __device__ __forceinline__ void operator()(const Acc& acc, const Unit& u, int wr, int wc, int fr, int fq) const {
        const int row0 = u.pm * 256 + wr * 64 + fr, colt = u.pn * 256 + wc * 32 + 8 * fq;
#pragma unroll
        for (int ai = 0; ai < 2; ++ai)
#pragma unroll
            for (int m = 0; m < 4; ++m) { const int r = row0 + ai * 128 + m * 16; float sq = 0.f;
#pragma unroll
                for (int bj = 0; bj < 2; ++bj) { const int c = colt + bj * 128;
                    const u32x4 gw = *(const u32x4*)(GB + (size_t)r * 512 + c);
                    const f32x4 b0 = *(const f32x4*)(bglu + c), b1 = *(const f32x4*)(bglu + c + 4);
                    const f32x4 a0 = acc[ai][bj][m][0] + b0, a1 = acc[ai][bj][m][1] + b1;
                    float o[8]; o[0] = bflo(gw.x) * sigm(a0[0]); o[1] = bfhi(gw.x) * sigm(a0[1]); o[2] = bflo(gw.y) * sigm(a0[2]); o[3] = bfhi(gw.y) * sigm(a0[3]);
                    o[4] = bflo(gw.z) * sigm(a1[0]); o[5] = bfhi(gw.z) * sigm(a1[1]); o[6] = bflo(gw.w) * sigm(a1[2]); o[7] = bfhi(gw.w) * sigm(a1[3]);
#pragma unroll
                    for (int e = 0; e < 8; ++e) sq += o[e] * o[e];
                    u32x4 w; w.x = pg8::cvt_pk_bf16(o[0], o[1]); w.y = pg8::cvt_pk_bf16(o[2], o[3]); w.z = pg8::cvt_pk_bf16(o[4], o[5]); w.w = pg8::cvt_pk_bf16(o[6], o[7]);
                    *(u32x4*)(MIX + (size_t)r * 1024 + c) = w; }
                sq += __shfl_xor(sq, 16); sq += __shfl_xor(sq, 32);
                if (fq == 0) atomicAdd(ssq + r, sq); }
    }
};
struct MidOut { static constexpr bool ON = true; const float* ssqb;
    __device__ __forceinline__ void operator()(Acc& acc, const Unit& u, int wr, int fr) const {
        if (u.nt != 16) return;
        const int row0 = u.pm * 256 + wr * 64 + fr;
#pragma unroll
        for (int ai = 0; ai < 2; ++ai)
#pragma unroll
            for (int m = 0; m < 4; ++m) { const float s = rsqrtf(ssqb[row0 + ai * 128 + m * 16] * (1.0f / 512.0f) + EPS);
#pragma unroll
                for (int bj = 0; bj < 2; ++bj)
#pragma unroll
                    for (int n = 0; n < 2; ++n) acc[ai][bj][m][n] *= s; }
    }
};
struct EpiOut { static constexpr bool PERM = true; const float* xp; const float* xs; float* H; bf16_t* HB; float* ssq; const float* ssqb; float* PART; const bf16_t* XB;
    __device__ __forceinline__ void operator()(const Acc& acc, const Unit& u, int wr, int wc, int fr, int fq) const {
        const int row0 = u.pm * 256 + wr * 64 + fr, colt = u.pn * 256 + wc * 32 + 8 * fq;
        if (u.nt != 16) {
#pragma unroll
            for (int ai = 0; ai < 2; ++ai)
#pragma unroll
                for (int m = 0; m < 4; ++m) { const int r = row0 + ai * 128 + m * 16; const float s = (u.k0 < 512) ? rsqrtf(ssqb[r] * (1.0f / 512.0f) + EPS) : 1.0f;
#pragma unroll
                    for (int bj = 0; bj < 2; ++bj) { float* q = PART + ((size_t)(u.k0 >> 8) * 512 + (r - MPR)) * 1024 + colt + bj * 128;
                        *(f32x4*)q = acc[ai][bj][m][0] * s; *(f32x4*)(q + 4) = acc[ai][bj][m][1] * s; } }
            return;
        }
#pragma unroll
        for (int ai = 0; ai < 2; ++ai)
#pragma unroll
            for (int m = 0; m < 4; ++m) { const int r = row0 + ai * 128 + m * 16; float sq = 0.f;
#pragma unroll
                for (int bj = 0; bj < 2; ++bj) { const int c = colt + bj * 128;
                    const u32x4 xw = *(const u32x4*)(XB + (size_t)r * 1024 + c);
                    const f32x4 h0 = (f32x4){bflo(xw.x), bfhi(xw.x), bflo(xw.y), bfhi(xw.y)} + acc[ai][bj][m][0], h1 = (f32x4){bflo(xw.z), bfhi(xw.z), bflo(xw.w), bfhi(xw.w)} + acc[ai][bj][m][1];
                    sq += h0[0] * h0[0] + h0[1] * h0[1] + h0[2] * h0[2] + h0[3] * h0[3] + h1[0] * h1[0] + h1[1] * h1[1] + h1[2] * h1[2] + h1[3] * h1[3];
                    u32x4 w; w.x = pg8::cvt_pk_bf16(h0[0], h0[1]); w.y = pg8::cvt_pk_bf16(h0[2], h0[3]); w.z = pg8::cvt_pk_bf16(h1[0], h1[1]); w.w = pg8::cvt_pk_bf16(h1[2], h1[3]);
                    *(u32x4*)(HB + (size_t)r * 1024 + c) = w; }
                sq += __shfl_xor(sq, 16); sq += __shfl_xor(sq, 32);
                if (fq == 0) atomicAdd(ssq + r, sq); }
    }
};
struct EpiUp { static constexpr bool PERM = true; const float* ssqh; bf16_t* ACT; bf16_t* HALO; bf16_t* HEAD; bf16_t* UPS; float* out; const float* cw; const float* cb;
    __device__ __forceinline__ void operator()(Acc& acc, const Unit& u, int wr, int wc, int fr, int fq) const {
        const int row0 = u.pm * 256 + wr * 64 + fr, j0 = u.pn * 128 + wc * 32 + 8 * fq;
#pragma unroll
        for (int ai = 0; ai < 2; ++ai)
#pragma unroll
            for (int m = 0; m < 4; ++m) { const float s = rsqrtf(ssqh[row0 + ai * 128 + m * 16] * (1.0f / 1024.0f) + EPS);
#pragma unroll
                for (int bj = 0; bj < 2; ++bj)
#pragma unroll
                    for (int n = 0; n < 2; ++n) acc[ai][bj][m][n] *= s; }
        if (u.pm >= 64) {
#pragma unroll
            for (int ai = 0; ai < 2; ++ai)
#pragma unroll
                for (int m = 0; m < 4; ++m) { const int rs = row0 + ai * 128 + m * 16 - MPR, j = rs & 3;
#pragma unroll
                    for (int bj = 0; bj < 2; ++bj) { const f32x4 v0 = acc[ai][bj][m][0], v1 = acc[ai][bj][m][1]; const int c = bj * FF + j0;
                        u32x4 w; w.x = pg8::cvt_pk_bf16(v0[0], v0[1]); w.y = pg8::cvt_pk_bf16(v0[2], v0[3]); w.z = pg8::cvt_pk_bf16(v1[0], v1[1]); w.w = pg8::cvt_pk_bf16(v1[2], v1[3]);
                        *(u32x4*)(UPS + (size_t)rs * FF2 + c) = w;
                        if (j >= 2) { float* o = out + O_CS + ((size_t)((rs >> 2) * 2 + (j - 2))) * FF2 + c; *(f32x4*)o = v0; *(f32x4*)(o + 4) = v1; } } }
            return;
        }
#pragma unroll
        for (int ai = 0; ai < 2; ++ai) { const int rb = row0 + ai * 128;
            if (fr >= 14) { const int r = rb + 48, k = r >> 6, pos = r & 2047;
#pragma unroll
                for (int bj = 0; bj < 2; ++bj) { const f32x4 v0 = acc[ai][bj][3][0], v1 = acc[ai][bj][3][1]; const int c = bj * FF + j0;
                    u32x4 w; w.x = pg8::cvt_pk_bf16(v0[0], v0[1]); w.y = pg8::cvt_pk_bf16(v0[2], v0[3]); w.z = pg8::cvt_pk_bf16(v1[0], v1[1]); w.w = pg8::cvt_pk_bf16(v1[2], v1[3]);
                    *(u32x4*)(HALO + (size_t)(k * 2 + (fr - 14)) * FF2 + c) = w;
                    if (pos >= 2046) { float* o = out + O_CP + ((size_t)((r >> 11) * 2 + (pos - 2046))) * FF2 + c; *(f32x4*)o = v0; *(f32x4*)(o + 4) = v1; } } }
            if (fr < 2) { const int k = rb >> 6;
#pragma unroll
                for (int bj = 0; bj < 2; ++bj) { const f32x4 v0 = acc[ai][bj][0][0], v1 = acc[ai][bj][0][1]; const int c = bj * FF + j0;
                    u32x4 w; w.x = pg8::cvt_pk_bf16(v0[0], v0[1]); w.y = pg8::cvt_pk_bf16(v0[2], v0[3]); w.z = pg8::cvt_pk_bf16(v1[0], v1[1]); w.w = pg8::cvt_pk_bf16(v1[2], v1[3]);
                    *(u32x4*)(HEAD + (size_t)(k * 2 + fr) * FF2 + c) = w; } } }
        u32x2 keep[2][4];
#pragma unroll
        for (int n = 0; n < 2; ++n) { const int j = j0 + 4 * n;
            const f32x4 wg0 = *(const f32x4*)(cw + j), wg1 = *(const f32x4*)(cw + FF2 + j), wg2 = *(const f32x4*)(cw + 2 * FF2 + j), bg = *(const f32x4*)(cb + j);
            const f32x4 wv0 = *(const f32x4*)(cw + FF + j), wv1 = *(const f32x4*)(cw + FF2 + FF + j), wv2 = *(const f32x4*)(cw + 2 * FF2 + FF + j), bv = *(const f32x4*)(cb + FF + j);
#pragma unroll
            for (int ai = 0; ai < 2; ++ai)
#pragma unroll
                for (int m = 0; m < 4; ++m) { const f32x4 cg = acc[ai][0][m][n], cv = acc[ai][1][m][n];
                    const f32x4 pg = acc[ai][0][m > 0 ? m - 1 : 0][n], pv = acc[ai][1][m > 0 ? m - 1 : 0][n];
                    f32x4 g1, g2, v1, v2;
#pragma unroll
                    for (int e = 0; e < 4; ++e) {
                        g1[e] = dpps<0x111>(dppf<0x121>(pg[e]), cg[e]); g2[e] = dpps<0x112>(dppf<0x122>(pg[e]), cg[e]);
                        v1[e] = dpps<0x111>(dppf<0x121>(pv[e]), cv[e]); v2[e] = dpps<0x112>(dppf<0x122>(pv[e]), cv[e]); }
                    const f32x4 ga = bg + wg0 * g2 + wg1 * g1 + wg2 * cg, va = bv + wv0 * v2 + wv1 * v1 + wv2 * cv;
                    const f32x4 zz = (ga + ga * ga * ga * 0.044715f) * (-2.3022082f);
                    f32x4 o;
#pragma unroll
                    for (int e = 0; e < 4; ++e) o[e] = __builtin_amdgcn_rcpf(1.0f + __builtin_amdgcn_exp2f(zz[e]));
                    o = o * ga * va;
                    u32x2 w; w.x = pg8::cvt_pk_bf16(o[0], o[1]); w.y = pg8::cvt_pk_bf16(o[2], o[3]);
                    if (n == 0) keep[ai][m] = w;
                    else { u32x4 w4; w4.x = keep[ai][m].x; w4.y = keep[ai][m].y; w4.z = w.x; w4.w = w.y; *(u32x4*)(ACT + act_off(row0 + ai * 128 + m * 16, j0)) = w4; asm volatile("" ::: "memory"); } } }
    }
};
struct EpiDown { static constexpr bool PERM = true; float* H; float* ssq; const bf16_t* HB; float* PART; bf16_t* HBW;
    __device__ __forceinline__ void operator()(const Acc& acc, const Unit& u, int wr, int wc, int fr, int fq) const {
        const int row0 = u.pm * 256 + wr * 64 + fr, colt = u.pn * 256 + wc * 32 + 8 * fq;
        const bool partial = (u.nt != FF / 64);
#pragma unroll
        for (int ai = 0; ai < 2; ++ai)
#pragma unroll
            for (int m = 0; m < 4; ++m) { const int r = row0 + ai * 128 + m * 16; float sq = 0.f;
#pragma unroll
                for (int bj = 0; bj < 2; ++bj) { const int c = colt + bj * 128; f32x4 h0 = acc[ai][bj][m][0], h1 = acc[ai][bj][m][1];
                    if (!partial || u.k0 == 0) { const u32x4 hw = *(const u32x4*)(HB + (size_t)r * 1024 + c);
                        h0 += (f32x4){bflo(hw.x), bfhi(hw.x), bflo(hw.y), bfhi(hw.y)}; h1 += (f32x4){bflo(hw.z), bfhi(hw.z), bflo(hw.w), bfhi(hw.w)}; }
                    if (partial) { float* q = PART + ((size_t)(u.k0 >> 8) * 512 + (r - MPR)) * 1024 + c; *(f32x4*)q = h0; *(f32x4*)(q + 4) = h1; }
                    else { sq += h0[0] * h0[0] + h0[1] * h0[1] + h0[2] * h0[2] + h0[3] * h0[3] + h1[0] * h1[0] + h1[1] * h1[1] + h1[2] * h1[2] + h1[3] * h1[3];
                        u32x4 w; w.x = pg8::cvt_pk_bf16(h0[0], h0[1]); w.y = pg8::cvt_pk_bf16(h0[2], h0[3]); w.z = pg8::cvt_pk_bf16(h1[0], h1[1]); w.w = pg8::cvt_pk_bf16(h1[2], h1[3]);
                        *(u32x4*)(HBW + (size_t)r * 1024 + c) = w; } }
                if (!partial) { sq += __shfl_xor(sq, 16); sq += __shfl_xor(sq, 32); if (fq == 0) atomicAdd(ssq + r, sq); } }
    }
};

__device__ __forceinline__ void tr_tile(const float* src, int N, int k0, int n0, bf16_t* dst, int ldd, int kd0, const float* sc, LAS float* tile, int tid, int dn0 = -1) {
    if (dn0 < 0) dn0 = n0;
    { const int tr = tid >> 5, tc = tid & 31; float4 v[4];
#pragma unroll
      for (int i = 0; i < 4; ++i) { const f32x4 a_ = __builtin_nontemporal_load((const f32x4*)(src + (size_t)(k0 + tr + i * 16) * N + n0 + tc * 4)); v[i] = make_float4(a_[0], a_[1], a_[2], a_[3]); }
#pragma unroll
      for (int i = 0; i < 4; ++i) { const int k = tr + i * 16; const float s = sc ? sc[k] : 1.0f;
          tile[k * 129 + tc * 4 + 0] = v[i].x * s; tile[k * 129 + tc * 4 + 1] = v[i].y * s; tile[k * 129 + tc * 4 + 2] = v[i].z * s; tile[k * 129 + tc * 4 + 3] = v[i].w * s; } }
    __syncthreads();
#pragma unroll
    for (int h = 0; h < 2; ++h) { const int wn = (tid >> 3) + h * 64, wk = tid & 7; float e[8];
#pragma unroll
      for (int j = 0; j < 8; ++j) e[j] = tile[(wk * 8 + j) * 129 + wn];
      u32x4 w; w.x = pk2(e[0], e[1]); w.y = pk2(e[2], e[3]); w.z = pk2(e[4], e[5]); w.w = pk2(e[6], e[7]);
      *(u32x4*)(dst + (size_t)(dn0 + wn) * ldd + kd0 + wk * 8) = w; }
    __syncthreads();
}

__device__ __forceinline__ void ssm_prep(KP kp, int g, int half, LAS float* L, int tid) {
    LAS float* apr = L;
    LAS float* api = L + 17 * 64;
    LAS float* bbr = L + 2 * 17 * 64;
    LAS float* bbi = bbr + 1024;
    LAS float* crr = bbi + 1024;
    LAS float* cii = crr + 1024;
    LAS float* frs = cii + 1024;
    LAS float* fis = frs + 64;
    LAS float* ktau = fis + 64;
    unsigned char* ws = p.ws;
    if (tid < 64) {
        const float dt = expf(p.log_dt[g]); const float lr = p.lam_re[g * 64 + tid], li = p.lam_im[g * 64 + tid];
        const float mag = expf(lr * dt), ang = li * dt; const float ar = mag * cosf(ang), ai = mag * sinf(ang);
        const float den = lr * lr + li * li;
        frs[tid] = ((ar - 1.0f) * lr + ai * li) / den; fis[tid] = (ai * lr - (ar - 1.0f) * li) / den;
        float pr = 1.f, pi = 0.f;
        for (int t = 0; t <= 16; ++t) { apr[t * 64 + tid] = pr; api[t * 64 + tid] = pi; const float nr = pr * ar - pi * ai, ni = pr * ai + pi * ar; pr = nr; pi = ni; }
        if (half == 0) { ((float*)(ws + W_A16))[g * 64 + tid] = apr[16 * 64 + tid]; ((float*)(ws + W_A16))[2048 + g * 64 + tid] = api[16 * 64 + tid]; }
        const float m2 = ar * ar + ai * ai; const float ir = ar / m2, ii = -ai / m2; float qr = 1.f, qi = 0.f;
        for (int t = 0; t < 12; ++t) { const float nr = qr * ir - qi * ii, ni = qr * ii + qi * ir; qr = nr; qi = ni; }
        if (half == 0) { ((float*)(ws + W_AM12))[g * 64 + tid] = qr; ((float*)(ws + W_AM12))[2048 + g * 64 + tid] = qi; }
    }
    for (int i = tid; i < 1024; i += 512) { crr[i] = p.c_re[g * 1024 + i]; cii[i] = p.c_im[g * 1024 + i]; }
    __syncthreads();
    for (int i = tid; i < 1024; i += 512) { const int pp = i >> 4; const float br = p.b_re[g * 1024 + i], bi = p.b_im[g * 1024 + i];
        bbr[i] = frs[pp] * br - fis[pp] * bi; bbi[i] = frs[pp] * bi + fis[pp] * br; }
    __syncthreads();
    for (int i2 = tid; i2 < 2048; i2 += 512) { const int tau = i2 >> 7, co = half * 8 + ((i2 >> 4) & 7), ci = i2 & 15, i = tau * 256 + co * 16 + ci; float s = 0.f;
        for (int pp = 0; pp < 64; ++pp) { const float cr = crr[co * 64 + pp], cim = cii[co * 64 + pp], pr = apr[tau * 64 + pp], pi = api[tau * 64 + pp];
            const float xr = cr * pr - cim * pi, xi = cr * pi + cim * pr; s += xr * bbr[pp * 16 + ci] - xi * bbi[pp * 16 + ci]; }
        ktau[i] = s; }
    __syncthreads();
    bf16_t* WY = (bf16_t*)(ws + W_WY) + (size_t)g * 256 * KY;
    for (int i = tid; i < 128 * 48; i += 512) { const int n2 = i / 48, k0 = (i % 48) * 8, t = n2 >> 3, co = half * 8 + (n2 & 7), n = t * 16 + co; float e[8];
        if (k0 < 256) { const int s = k0 >> 4, ci0 = k0 & 15;
#pragma unroll
            for (int j = 0; j < 8; ++j) e[j] = (t >= s) ? ktau[(t - s) * 256 + co * 16 + ci0 + j] : 0.f; }
        else { const int kk = k0 - 256, ri = kk >> 6, p0 = kk & 63;
#pragma unroll
            for (int j = 0; j < 8; ++j) { const int pp = p0 + j; const float cr = crr[co * 64 + pp], cim = cii[co * 64 + pp], pr = apr[(t + 1) * 64 + pp], pi = api[(t + 1) * 64 + pp];
                e[j] = ri == 0 ? (cr * pr - cim * pi) : -(cr * pi + cim * pr); } }
        u32x4 w; w.x = pk2(e[0], e[1]); w.y = pk2(e[2], e[3]); w.z = pk2(e[4], e[5]); w.w = pk2(e[6], e[7]);
        *(u32x4*)(WY + (size_t)n * KY + k0) = w; }
    bf16_t* WE = (bf16_t*)(ws + W_WE) + (size_t)g * 256 * 256;
    for (int i = tid; i < 64 * 32; i += 512) { const int ri = half, pp = i >> 5, n = ri * 64 + pp, k0 = (i & 31) * 8, s = k0 >> 4, ci0 = k0 & 15; float e[8];
        const float pr = apr[(15 - s) * 64 + pp], pi = api[(15 - s) * 64 + pp];
#pragma unroll
        for (int j = 0; j < 8; ++j) { const float br = bbr[pp * 16 + ci0 + j], bi = bbi[pp * 16 + ci0 + j]; e[j] = ri == 0 ? (pr * br - pi * bi) : (pr * bi + pi * br); }
        u32x4 w; w.x = pk2(e[0], e[1]); w.y = pk2(e[2], e[3]); w.z = pk2(e[4], e[5]); w.w = pk2(e[6], e[7]);
        *(u32x4*)(WE + (size_t)n * 256 + k0) = w; }
    __syncthreads();
}

__device__ __forceinline__ void tr_do(KP kp, LAS float* tile, int tid, int ti) {
    unsigned char* ws = p.ws;
    if (ti < 192) { const int kt = ti / 12, nt = ti % 12; tr_tile(p.w_in, NPROJ, kt * 64, nt * 128, (bf16_t*)(ws + W_WIN), 1024, kt * 64, p.g_mix + kt * 64, tile, tid); }
    else if (ti < 224) { const int t2 = ti - 192, kt = t2 / 4, nt = t2 % 4; tr_tile(p.w_glu, 512, kt * 64, nt * 128, (bf16_t*)(ws + W_WGLU), 512, kt * 64, nullptr, tile, tid); }
    else if (ti < 352) { const int t2 = ti - 224, kt = t2 / 8, nt = t2 % 8; const int k0 = kt * 64;
        tr_tile(p.w_out, 1024, k0, nt * 128, (bf16_t*)(ws + W_WOUT), 1024, (k0 + 512) & 1023, k0 < 512 ? p.g_out_a + k0 : p.g_out_b + (k0 - 512), tile, tid); }
    else if (ti < 1056) { const int t2 = ti - 352, kt = t2 / 44, nt = t2 % 44; const int jn = nt * 128, hb = jn >= FF ? 1 : 0, jj = jn - hb * FF;
        tr_tile(p.w_ffn_in, FF2, kt * 64, jn, (bf16_t*)(ws + W_WUP), 1024, kt * 64, p.g_ffn + kt * 64, tile, tid, (jj >> 7) * 256 + hb * 128); }
    else { const int t2 = ti - 1056, kt = t2 / 8, nt = t2 % 8, n0 = nt * 128;
        tr_tile(p.w_ffn_out, 1024, kt * 64, n0, (bf16_t*)(ws + W_WDN), 64, 0, nullptr, tile, tid, ((n0 >> 8) * (FF / 64) + kt) * 256 + (n0 & 255)); }
}
__device__ __forceinline__ void tr_range(KP kp, LAS unsigned char* lds, int lo, int hi, int idx, int stride) {
    __syncthreads();
    for (int ti = lo + idx; ti < hi; ti += stride) tr_do(kp, (LAS float*)lds, threadIdx.x, ti);
}

__device__ __forceinline__ void phase0(KP kp, LAS unsigned char* lds) {
    const int tid = threadIdx.x, bid = blockIdx.x, G = gridDim.x, lane = tid & 63, wid = tid >> 6;
    unsigned char* ws = p.ws;
    { const int gt = bid * 512 + tid, GT = G * 512;
      float* z = (float*)(ws + W_SSQB); for (int i = gt; i < 3 * MTOK; i += GT) z[i] = 0.f;
      float* za = (float*)(ws + W_SSQA); for (int i = gt; i < MTOK; i += GT) za[i] = 0.f;
      bf16_t* wt = (bf16_t*)(ws + W_WTRIL); for (int i = gt; i < 65536; i += GT) { const int t = (i >> 7) & 127, s = i & 127; wt[i] = f2bf(s <= t ? p.w_s[i] : 0.f); }
      unsigned* ag = (unsigned*)(ws + W_AG);
      for (int i = gt; i < 32 * 128 * 96; i += GT) { const int gg = i / (128 * 96), rem = i % (128 * 96), b = rem / 96, k2 = rem % 96; ag[((size_t)(gg * MC16 + 1024 + b) * KY) / 2 + k2] = 0u; } }
    { bf16_t* XB = (bf16_t*)(ws + W_XB); float* R1 = (float*)(ws + W_R1);
      for (int row = (bid * 8 + wid) * 2; row < MTOK; row += G * 16) {
          float4 v[2][4]; float sq[2] = {0.f, 0.f};
#pragma unroll
          for (int rr = 0; rr < 2; ++rr) { const int r = row + rr; const float* src = r < MPR ? p.x_prompt + (size_t)r * 1024 : p.x_sample + (size_t)(r - MPR) * 1024;
#pragma unroll
              for (int i = 0; i < 2; ++i) { const f32x4 a_ = __builtin_nontemporal_load((const f32x4*)(src + i * 512 + lane * 8)), b_ = __builtin_nontemporal_load((const f32x4*)(src + i * 512 + lane * 8 + 4));
                  v[rr][2 * i] = make_float4(a_[0], a_[1], a_[2], a_[3]); v[rr][2 * i + 1] = make_float4(b_[0], b_[1], b_[2], b_[3]); } }
#pragma unroll
          for (int rr = 0; rr < 2; ++rr) {
#pragma unroll
              for (int i = 0; i < 4; ++i) sq[rr] += v[rr][i].x * v[rr][i].x + v[rr][i].y * v[rr][i].y + v[rr][i].z * v[rr][i].z + v[rr][i].w * v[rr][i].w;
#pragma unroll
              for (int o = 32; o >= 1; o >>= 1) sq[rr] += __shfl_xor(sq[rr], o);
              if (lane == 0) R1[row + rr] = rsqrtf(sq[rr] * (1.0f / 1024.0f) + EPS);
#pragma unroll
              for (int i = 0; i < 2; ++i) { u32x4 w; w.x = pk2(v[rr][2 * i].x, v[rr][2 * i].y); w.y = pk2(v[rr][2 * i].z, v[rr][2 * i].w); w.z = pk2(v[rr][2 * i + 1].x, v[rr][2 * i + 1].y); w.w = pk2(v[rr][2 * i + 1].z, v[rr][2 * i + 1].w);
                  *(u32x4*)(XB + (size_t)(row + rr) * 1024 + i * 512 + lane * 8) = w; } } } }
    LAS float* tile = (LAS float*)lds;
    for (int ti = bid; ti < 192; ti += G) tr_do(kp, tile, tid, ti);
}

__device__ __forceinline__ void sgu_phase(KP kp, LAS unsigned char* lds, int first_item_offset) {
    const int tid = threadIdx.x, G = gridDim.x, lane = tid & 63, wid = tid >> 6, fr = lane & 15, fq = lane >> 4;
    unsigned char* ws = p.ws;
    const bf16_t* U = (const bf16_t*)(ws + W_U); const bf16_t* V = (const bf16_t*)(ws + W_V); const bf16_t* WT = (const bf16_t*)(ws + W_WTRIL);
    bf16_t* AOUT = (bf16_t*)(ws + W_AOUT); float* SSQA = (float*)(ws + W_SSQA);
    LAS bf16_t* vnT = (LAS bf16_t*)lds;
    const bool free_wg = (G == 256) && ((int)blockIdx.x >= first_item_offset);
    const int it0 = (G == 256) ? (free_wg ? (int)blockIdx.x - first_item_offset : 384 + (int)blockIdx.x) : (int)blockIdx.x;
    const int itstep = (G == 256) ? (free_wg ? G - first_item_offset : 1024) : G, itend = (G == 256 && free_wg) ? 384 : 516;
    for (int item = it0; item < itend; item += itstep) {
        if (item < 512) {
            const int t0 = (item >> 2) * 128, tb = wid, trow = tb * 16 + fr;
            float sq = 0.f;
            { const int h = item & 3;
                const int nk = (tb >> 1) + 1; bf16x8 wfr[4];
#pragma unroll
                for (int ks = 0; ks < 4; ++ks) if (ks < nk) wfr[ks] = *(const bf16x8*)(WT + (size_t)(h * 128 + trow) * 128 + ks * 32 + fq * 8);
                { const int row = tid >> 2, q = tid & 3; const bf16_t* vp = V + (size_t)(t0 + row) * 512 + h * 128 + q * 32;
                  u32x4 w[4]; float s2 = 0.f;
#pragma unroll
                  for (int i = 0; i < 4; ++i) { w[i] = *(const u32x4*)(vp + i * 8);
                      const float a0 = bflo(w[i].x), a1 = bfhi(w[i].x), a2 = bflo(w[i].y), a3 = bfhi(w[i].y), a4 = bflo(w[i].z), a5 = bfhi(w[i].z), a6 = bflo(w[i].w), a7 = bfhi(w[i].w);
                      s2 += a0 * a0 + a1 * a1 + a2 * a2 + a3 * a3 + a4 * a4 + a5 * a5 + a6 * a6 + a7 * a7; }
                  s2 += __shfl_xor(s2, 1); s2 += __shfl_xor(s2, 2);
                  const float rs = rsqrtf(s2 * (1.0f / 128.0f) + EPS); const float* gv = p.g_v + h * 128 + q * 32;
#pragma unroll
                  for (int i = 0; i < 4; ++i) { const unsigned ww[4] = {w[i].x, w[i].y, w[i].z, w[i].w};
#pragma unroll
                      for (int j = 0; j < 4; ++j) { const int d = q * 32 + i * 8 + j * 2;
                          vnT[d * 136 + row] = f2bf(bflo(ww[j]) * rs * gv[i * 8 + j * 2]); vnT[(d + 1) * 136 + row] = f2bf(bfhi(ww[j]) * rs * gv[i * 8 + j * 2 + 1]); } } }
                __syncthreads();
                f32x4 acc[8];
#pragma unroll
                for (int db = 0; db < 8; ++db) acc[db] = (f32x4){0.f, 0.f, 0.f, 0.f};
#pragma unroll
                for (int ks = 0; ks < 4; ++ks) if (ks < nk) {
                    const bf16x8 wf = wfr[ks];
#pragma unroll
                    for (int db = 0; db < 8; ++db) { const bf16x8 xf = *(const LAS bf16x8*)(vnT + (db * 16 + fr) * 136 + ks * 32 + fq * 8);
                        acc[db] = __builtin_amdgcn_mfma_f32_16x16x32_bf16(xf, wf, acc[db], 0, 0, 0); }
                }
                const float bs = p.b_s[h * 128 + trow];
#pragma unroll
                for (int db = 0; db < 8; ++db) { const u32x2 uw = *(const u32x2*)(U + (size_t)(t0 + trow) * 512 + h * 128 + db * 16 + 4 * fq);
                    const float a0 = bflo(uw.x) * (acc[db][0] + bs), a1 = bfhi(uw.x) * (acc[db][1] + bs), a2 = bflo(uw.y) * (acc[db][2] + bs), a3 = bfhi(uw.y) * (acc[db][3] + bs);
                    sq += a0 * a0 + a1 * a1 + a2 * a2 + a3 * a3; u32x2 w; w.x = pk2(a0, a1); w.y = pk2(a2, a3);
                    *(u32x2*)(AOUT + (size_t)(t0 + trow) * 512 + h * 128 + db * 16 + 4 * fq) = w;
#ifdef SGU_DIRECT
                    *(f32x4*)((float*)(ws + W_HB) + (size_t)(t0 + trow) * 512 + h * 128 + db * 16 + 4 * fq) = (f32x4){a0, a1, a2, a3};
#endif
 }
                __syncthreads();
            }
            sq += __shfl_xor(sq, 16); sq += __shfl_xor(sq, 32);
            if (fq == 0) atomicAdd(SSQA + t0 + trow, sq);
        } else {
            const int sc = item - 512, sqn = tid >> 4, h = (tid >> 2) & 3, dq = tid & 3, b = sc * 32 + sqn, row0 = MPR + b * 4;
            float rs[4];
#pragma unroll
            for (int j = 0; j < 4; ++j) { const bf16_t* vp = V + (size_t)(row0 + j) * 512 + h * 128 + dq * 32; float s2 = 0.f;
#pragma unroll
                for (int i = 0; i < 4; ++i) { const u32x4 w = *(const u32x4*)(vp + i * 8); const unsigned ww[4] = {w.x, w.y, w.z, w.w};
#pragma unroll
                    for (int k = 0; k < 4; ++k) { const float a = bflo(ww[k]), c = bfhi(ww[k]); s2 += a * a + c * c; } }
                s2 += __shfl_xor(s2, 1); s2 += __shfl_xor(s2, 2); rs[j] = rsqrtf(s2 * (1.0f / 128.0f) + EPS); }
            float wsj[4][4], bsj[4];
#pragma unroll
            for (int j = 0; j < 4; ++j) { bsj[j] = p.b_s[h * 128 + j];
#pragma unroll
                for (int k = 0; k < 4; ++k) wsj[j][k] = (k <= j) ? p.w_s[(size_t)(h * 128 + j) * 128 + k] : 0.f; }
            float ssa[4] = {0.f, 0.f, 0.f, 0.f};
            { const int sweep = 0;
                for (int i = 0; i < 4; ++i) { const int d0 = dq * 32 + i * 8; float vn[4][8];
#pragma unroll
                    for (int j = 0; j < 4; ++j) { const u32x4 w = *(const u32x4*)(V + (size_t)(row0 + j) * 512 + h * 128 + d0); const unsigned ww[4] = {w.x, w.y, w.z, w.w};
#pragma unroll
                        for (int k = 0; k < 4; ++k) { vn[j][2 * k] = bflo(ww[k]) * rs[j] * p.g_v[h * 128 + d0 + 2 * k]; vn[j][2 * k + 1] = bfhi(ww[k]) * rs[j] * p.g_v[h * 128 + d0 + 2 * k + 1]; }
                        if (sweep == 0) { float* o = p.out + O_VS + ((size_t)((b * 4 + j) * 4 + h)) * 128 + d0;
                            *(f32x4*)o = (f32x4){vn[j][0], vn[j][1], vn[j][2], vn[j][3]}; *(f32x4*)(o + 4) = (f32x4){vn[j][4], vn[j][5], vn[j][6], vn[j][7]}; } }
#pragma unroll
                    for (int j = 0; j < 4; ++j) { const u32x4 uw = *(const u32x4*)(U + (size_t)(row0 + j) * 512 + h * 128 + d0); const unsigned uu[4] = {uw.x, uw.y, uw.z, uw.w}; float a[8];
#pragma unroll
                        for (int e = 0; e < 8; ++e) { float s = bsj[j];
#pragma unroll
                            for (int k = 0; k < 4; ++k) s += wsj[j][k] * vn[k][e];
                            const float uv = (e & 1) ? bfhi(uu[e >> 1]) : bflo(uu[e >> 1]); a[e] = uv * s; }
#pragma unroll
                        for (int e = 0; e < 8; ++e) ssa[j] += a[e] * a[e];
                        { u32x4 w; w.x = pk2(a[0], a[1]); w.y = pk2(a[2], a[3]); w.z = pk2(a[4], a[5]); w.w = pk2(a[6], a[7]);
                            *(u32x4*)(AOUT + (size_t)(row0 + j) * 512 + h * 128 + d0) = w; } } }
#pragma unroll
                for (int j = 0; j < 4; ++j) { float s = ssa[j]; s += __shfl_xor(s, 1); s += __shfl_xor(s, 2); s += __shfl_xor(s, 4); s += __shfl_xor(s, 8); if ((tid & 15) == 0) SSQA[row0 + j] = s; }
            }
        }
    }
}

__device__ __forceinline__ void scan_phase(KP kp) {
    unsigned char* ws = p.ws; const float* EB = (const float*)(ws + W_EB); bf16_t* AG = (bf16_t*)(ws + W_AG);
    const float* A16 = (const float*)(ws + W_A16); const float* AM12 = (const float*)(ws + W_AM12);
    const int GT = gridDim.x * 512;
    for (int id = blockIdx.x * 512 + threadIdx.x; id < 16384 * 8; id += GT) {
        const int seg = id & 7, sid = id >> 3, b = sid >> 11, gp = sid & 2047, gg = gp >> 6, pp = gp & 63; const float ar = A16[gp], ai = A16[2048 + gp];
        const size_t rbase = (size_t)gg * MC16 + b * 128 + seg * 16;
        float er[16], ei[16];
#pragma unroll
        for (int k = 0; k < 16; ++k) { er[k] = EB[(rbase + k) * 128 + pp]; ei[k] = EB[(rbase + k) * 128 + 64 + pp]; }
        float hr = 0.f, hi = 0.f;
#pragma unroll
        for (int k = 0; k < 16; ++k) { const float nr = ar * hr - ai * hi + er[k], ni = ar * hi + ai * hr + ei[k]; hr = nr; hi = ni; }
        float mr = ar, mi = ai;
#pragma unroll
        for (int q = 0; q < 4; ++q) { const float nr = mr * mr - mi * mi, ni = 2.f * mr * mi; mr = nr; mi = ni; }
#pragma unroll
        for (int d = 1; d < 8; d <<= 1) {
            const float hpr = __shfl_up(hr, d, 8), hpi = __shfl_up(hi, d, 8), mpr = __shfl_up(mr, d, 8), mpi = __shfl_up(mi, d, 8);
            if (seg >= d) { const float nhr = hr + mr * hpr - mi * hpi, nhi = hi + mr * hpi + mi * hpr, nmr = mr * mpr - mi * mpi, nmi = mr * mpi + mi * mpr; hr = nhr; hi = nhi; mr = nmr; mi = nmi; } }
        float cr = __shfl_up(hr, 1, 8), ci = __shfl_up(hi, 1, 8); if (seg == 0) { cr = 0.f; ci = 0.f; }
#pragma unroll
        for (int k = 0; k < 16; ++k) { bf16_t* hp = AG + (rbase + k) * KY + 256 + pp; hp[0] = f2bf(cr); hp[64] = f2bf(ci);
            const float nr = ar * cr - ai * ci + er[k], ni = ar * ci + ai * cr + ei[k]; cr = nr; ci = ni; }
        if (seg == 7) { p.out[O_SRP + sid] = cr; p.out[O_SIP + sid] = ci; }
    }
    for (int id = 16384 + blockIdx.x * 512 + threadIdx.x; id < (8 + 128) * 2048; id += GT) {
        if (false) {
        } else { const int id2 = id - 16384, b = id2 >> 11, gp = id2 & 2047, gg = gp >> 6, pp = gp & 63;
            const float sr = p.st_re[id2], si = p.st_im[id2], qr = AM12[gp], qi = AM12[2048 + gp];
            const float hr = sr * qr - si * qi, hi = sr * qi + si * qr; const size_t row = (size_t)gg * MC16 + 1024 + b;
            bf16_t* hp = AG + row * KY + 256 + pp; hp[0] = f2bf(hr); hp[64] = f2bf(hi);
            const float ar = A16[gp], ai = A16[2048 + gp];
            p.out[O_SRS + id2] = ar * hr - ai * hi + EB[row * 128 + pp]; p.out[O_SIS + id2] = ar * hi + ai * hr + EB[row * 128 + 64 + pp]; }
    }
    { bf16_t* MIX = (bf16_t*)(ws + W_MIX); const bf16_t* AOUT = (const bf16_t*)(ws + W_AOUT); const float* SSQA = (const float*)(ws + W_SSQA);
      for (int i = blockIdx.x * 512 + threadIdx.x; i < MTOK * 64; i += GT) { const int r = i >> 6, c = (i & 63) * 8; const float ra = rsqrtf(SSQA[r] * (1.0f / 512.0f) + EPS);
          u32x4* mp = (u32x4*)(MIX + (size_t)r * 1024 + 512 + c); const u32x4 o = *(const u32x4*)(AOUT + (size_t)r * 512 + c); u32x4 w;
          w.x = pk2(bflo(o.x) * ra, bfhi(o.x) * ra); w.y = pk2(bflo(o.y) * ra, bfhi(o.y) * ra); w.z = pk2(bflo(o.z) * ra, bfhi(o.z) * ra); w.w = pk2(bflo(o.w) * ra, bfhi(o.w) * ra); *mp = w; } }
}

__device__ __forceinline__ void ld8bf(const bf16_t* q, float (&o)[8]) { const u32x4 w = *(const u32x4*)q; o[0] = bflo(w.x); o[1] = bfhi(w.x); o[2] = bflo(w.y); o[3] = bfhi(w.y); o[4] = bflo(w.z); o[5] = bfhi(w.z); o[6] = bflo(w.w); o[7] = bfhi(w.w); }
__device__ __forceinline__ void ld8f(const float* q, float (&o)[8]) { const f32x4 a = *(const f32x4*)q, b = *(const f32x4*)(q + 4); o[0] = a[0]; o[1] = a[1]; o[2] = a[2]; o[3] = a[3]; o[4] = b[0]; o[5] = b[1]; o[6] = b[2]; o[7] = b[3]; }
__device__ __forceinline__ void act_phase(KP kp) {
    unsigned char* ws = p.ws; bf16_t* ACT = (bf16_t*)(ws + W_ACT); const bf16_t* HALO = (const bf16_t*)(ws + W_HALO); const bf16_t* HEAD = (const bf16_t*)(ws + W_HEAD); const bf16_t* UPS = (const bf16_t*)(ws + W_UPS);
    const int GT = gridDim.x * 512, gt = blockIdx.x * 512 + threadIdx.x;
    const float* cw = p.conv_w; const float* cb = p.conv_b;
    for (int e = gt; e < (512 + 512) * 352; e += GT) {
        const int rowi = e / 352, col = (e % 352) * 8;
        float ga[8], va[8], t[8], w[8]; int orow;
        ld8f(cb + col, ga); ld8f(cb + FF + col, va);
        if (rowi < 512) { const int k = rowi >> 1, rr = rowi & 1; const bool hist = ((k * 64) & 2047) != 0; orow = k * 64 + rr;
#pragma unroll
            for (int q = 0; q < 3; ++q) { const int idx = rr + q - 2; const bf16_t* src = nullptr;
                if (idx >= 0) src = HEAD + (size_t)(k * 2 + idx) * FF2 + col; else if (hist) src = HALO + (size_t)((k - 1) * 2 + idx + 2) * FF2 + col;
                if (src) { ld8bf(src, t); ld8f(cw + q * FF2 + col, w);
#pragma unroll
                    for (int i = 0; i < 8; ++i) ga[i] += w[i] * t[i];
                    ld8bf(src + FF, t); ld8f(cw + q * FF2 + FF + col, w);
#pragma unroll
                    for (int i = 0; i < 8; ++i) va[i] += w[i] * t[i]; } } }
        else { const int rs = rowi - 512, b = rs >> 2, j = rs & 3; orow = MPR + rs;
#pragma unroll
            for (int q = 0; q < 3; ++q) { const int idx = j + q - 2;
                if (idx >= 0) { const bf16_t* src = UPS + (size_t)(b * 4 + idx) * FF2 + col; ld8bf(src, t); ld8f(cw + q * FF2 + col, w);
#pragma unroll
                    for (int i = 0; i < 8; ++i) ga[i] += w[i] * t[i];
                    ld8bf(src + FF, t); ld8f(cw + q * FF2 + FF + col, w);
#pragma unroll
                    for (int i = 0; i < 8; ++i) va[i] += w[i] * t[i]; }
                else { const float* src = p.st_conv + (size_t)(b * 2 + idx + 2) * FF2 + col; ld8f(src, t); ld8f(cw + q * FF2 + col, w);
#pragma unroll
                    for (int i = 0; i < 8; ++i) ga[i] += w[i] * t[i];
                    ld8f(src + FF, t); ld8f(cw + q * FF2 + FF + col, w);
#pragma unroll
                    for (int i = 0; i < 8; ++i) va[i] += w[i] * t[i]; } } }
        u32x4 o; o.x = pk2(gelu_t(ga[0]) * va[0], gelu_t(ga[1]) * va[1]); o.y = pk2(gelu_t(ga[2]) * va[2], gelu_t(ga[3]) * va[3]);
        o.z = pk2(gelu_t(ga[4]) * va[4], gelu_t(ga[5]) * va[5]); o.w = pk2(gelu_t(ga[6]) * va[6], gelu_t(ga[7]) * va[7]);
        *(u32x4*)(ACT + act_off(orow, col)) = o;
    }
}

__device__ __forceinline__ void final_phase(KP kp) {
    const float* ssq = (const float*)(p.ws + W_SSQF); const int GT = gridDim.x * 512;
    for (int i = blockIdx.x * 512 + threadIdx.x; i < MPR * 128; i += GT) { const int r = i >> 7, c = (i & 127) * 8;
        const float s = rsqrtf(ssq[r] * (1.0f / 1024.0f) + EPS); float* hp = p.out + (size_t)r * 1024 + c; const f32x4 g0 = *(const f32x4*)(p.g_final + c), g1 = *(const f32x4*)(p.g_final + c + 4);
        const u32x4 hw = *(const u32x4*)((const bf16_t*)(p.ws + W_HB) + (size_t)r * 1024 + c);
        __builtin_nontemporal_store((f32x4){bflo(hw.x), bfhi(hw.x), bflo(hw.y), bfhi(hw.y)} * s * g0, (f32x4*)hp); __builtin_nontemporal_store((f32x4){bflo(hw.z), bfhi(hw.z), bflo(hw.w), bfhi(hw.w)} * s * g1, (f32x4*)(hp + 4)); }
    const int lane = threadIdx.x & 63, wv = blockIdx.x * 8 + (threadIdx.x >> 6);
    const float* PART = (const float*)(p.ws + W_PART);
    for (int r = MPR + wv; r < MTOK; r += gridDim.x * 8) { f32x4* hp = (f32x4*)(p.out + (size_t)r * 1024); f32x4 v[4]; float sq = 0.f;
#pragma unroll
        for (int i = 0; i < 4; ++i) { v[i] = (f32x4){0.f, 0.f, 0.f, 0.f};
            for (int kc = 0; kc < 11; ++kc) v[i] += ((const f32x4*)(PART + ((size_t)kc * 512 + (r - MPR)) * 1024))[lane + i * 64];
            sq += v[i][0] * v[i][0] + v[i][1] * v[i][1] + v[i][2] * v[i][2] + v[i][3] * v[i][3]; }
#pragma unroll
        for (int o = 32; o >= 1; o >>= 1) sq += __shfl_xor(sq, o);
        const float s = rsqrtf(sq * (1.0f / 1024.0f) + EPS);
#pragma unroll
        for (int i = 0; i < 4; ++i) hp[lane + i * 64] = v[i] * s * ((const f32x4*)p.g_final)[lane + i * 64]; }
}

__global__ void __launch_bounds__(512, 2) fwd_kernel(Params p_unused) {
    extern __shared__ __attribute__((aligned(16))) unsigned char shm[];
    KP kp = (KP)__builtin_amdgcn_kernarg_segment_ptr();
    LAS unsigned char* lds = (LAS unsigned char*)shm;
    cg::grid_group grid = cg::this_grid();
    unsigned char* ws = p.ws; const int G = gridDim.x, bid = blockIdx.x;
    const int lo = p.ph_lo, hi = p.ph_hi;
    if (threadIdx.x < 2) ((volatile LAS unsigned*)(lds + 131072))[threadIdx.x] = 0u;
    __syncthreads();
    if (threadIdx.x == 0) (void)xb_add(&((unsigned*)(p.ws + W_BAR))[XB_XCNT(xb_xcc_id())], 1u);
    if (lo < 0) grid.sync();
    const int cid = bid;
#ifndef PHMASK
#define PHMASK 0x7ff
#endif
#define IN(k) (((PHMASK >> (k)) & 1) && lo <= (k) && (k) < hi)
#define GSYNC() xcd_barrier((unsigned*)(p.ws + W_BAR), (volatile LAS unsigned*)(lds + 131072))
#define SYNC(k) do { if (IN(k) && IN((k) + 1)) GSYNC(); } while (0)
    if (IN(0)) { phase0(kp, lds); } SYNC(0);
    if (IN(1)) { pg8::Gemm g = pg8::gemm_rm((const bf16_t*)(ws + W_XB), (const bf16_t*)(ws + W_WIN), 1024, 1024); pg8::StaticOrder S; S.init(MTOK, NPROJ, 1024, G, cid);
        EpiProj E{(const float*)(ws + W_R1), (bf16_t*)(ws + W_U), (bf16_t*)(ws + W_V), (bf16_t*)(ws + W_AG)};
        pg8::gemm_phase(lds, g, S, E, pg8::NoMid{});
        if (cid >= G - 64) { __syncthreads(); ssm_prep(kp, (cid - (G - 64)) >> 1, (cid - (G - 64)) & 1, (LAS float*)lds, threadIdx.x); }
        else if (cid >= 140) tr_range(kp, lds, 1056, 1408, cid - 140, G - 64 - 140); } SYNC(1);
    if (IN(2)) { { pg8::Gemm g = pg8::gemm_rm((const bf16_t*)(ws + W_AG), (const bf16_t*)(ws + W_WE), KY, 256); pg8::BatchedOrder S{160, 5, G, bid, 4}; EpiE E{(float*)(ws + W_EB)};
          pg8::gemm_phase(lds, g, S, E, pg8::NoMid{}); }
        __syncthreads();
        sgu_phase(kp, lds, 160); } SYNC(2);
    if (IN(3)) { scan_phase(kp); tr_range(kp, lds, 192, 352, bid, G); } SYNC(3);
    if (IN(4)) { pg8::Gemm g = pg8::gemm_rm((const bf16_t*)(ws + W_AG), (const bf16_t*)(ws + W_WY), KY, KY); pg8::BatchedOrder S{160, 5, G, bid, 6};
        EpiY E{(const bf16_t*)(ws + W_AG), p.d_skip, (bf16_t*)(ws + W_GB)};
        pg8::gemm_phase(lds, g, S, E, pg8::NoMid{});
        if (bid >= 160) tr_range(kp, lds, 352, 1056, bid - 160, G - 160); } SYNC(4);
    if (IN(5)) { pg8::Gemm g = pg8::gemm_rm((const bf16_t*)(ws + W_GB), (const bf16_t*)(ws + W_WGLU), 512, 512); pg8::StaticOrder S; S.init(MTOK, 512, 512, G, cid);
        EpiGlu E{(const bf16_t*)(ws + W_GB), p.b_glu, (bf16_t*)(ws + W_MIX), (float*)(ws + W_SSQB)};
        pg8::gemm_phase(lds, g, S, E, pg8::NoMid{}); } SYNC(5);
    if (IN(6)) { pg8::Gemm g = pg8::gemm_rm((const bf16_t*)(ws + W_MIX), (const bf16_t*)(ws + W_WOUT), 1024, 1024); pg8::SplitOrder S; S.init(MPR, 1024, 1024, G, cid);
        EpiOut E{p.x_prompt, p.x_sample, p.out, (bf16_t*)(ws + W_HB), (float*)(ws + W_SSQH), (const float*)(ws + W_SSQB), (float*)(ws + W_PART), (const bf16_t*)(ws + W_XB)}; MidOut MD{(const float*)(ws + W_SSQB)};
        pg8::gemm_phase(lds, g, S, E, MD);
        GSYNC();
        {
            const int lane = threadIdx.x & 63; const float* PART = (const float*)(ws + W_PART); bf16_t* HB = (bf16_t*)(ws + W_HB); float* SSQH = (float*)(ws + W_SSQH);
            for (int rs = bid * 8 + (threadIdx.x >> 6); rs < 512; rs += G * 8) { float sq = 0.f;
#pragma unroll
                for (int i = 0; i < 4; ++i) { f32x4 v = ((const f32x4*)(p.x_sample + (size_t)rs * 1024))[lane + i * 64];
#pragma unroll
                    for (int kc = 0; kc < 4; ++kc) v += ((const f32x4*)(PART + ((size_t)kc * 512 + rs) * 1024))[lane + i * 64];
                    sq += v[0] * v[0] + v[1] * v[1] + v[2] * v[2] + v[3] * v[3];
                    u32x2 w; w.x = pk2(v[0], v[1]); w.y = pk2(v[2], v[3]); ((u32x2*)(HB + (size_t)(MPR + rs) * 1024))[lane + i * 64] = w; }
#pragma unroll
                for (int o = 32; o >= 1; o >>= 1) sq += __shfl_xor(sq, o);
                if (lane == 0) SSQH[MPR + rs] = sq; } } } SYNC(6);
    if (IN(7)) { pg8::Gemm g = pg8::gemm_rm((const bf16_t*)(ws + W_HB), (const bf16_t*)(ws + W_WUP), 1024, 1024); pg8::StaticOrder S; S.init(MTOK, FF2, 1024, G, cid);
        EpiUp E{(const float*)(ws + W_SSQH), (bf16_t*)(ws + W_ACT), (bf16_t*)(ws + W_HALO), (bf16_t*)(ws + W_HEAD), (bf16_t*)(ws + W_UPS), p.out, p.conv_w, p.conv_b};
        pg8::gemm_phase(lds, g, S, E, pg8::NoMid{}); } SYNC(7);
    if (IN(8)) { act_phase(kp); } SYNC(8);
    if (IN(9)) { pg8::Gemm g{(const bf16_t*)(ws + W_ACT), (const bf16_t*)(ws + W_WDN), 64, 64, 32768, 32768, (size_t)32768 * (FF / 64), (size_t)32768 * (FF / 64)}; pg8::SplitOrder S; S.init(MPR, 1024, FF, G, cid);
        EpiDown E{p.out, (float*)(ws + W_SSQF), (const bf16_t*)(ws + W_HB), (float*)(ws + W_PART), (bf16_t*)(ws + W_HB)};
        pg8::gemm_phase(lds, g, S, E, pg8::NoMid{}); } SYNC(9);
    if (IN(10)) { final_phase(kp); }
#ifdef DUMP_OFF
    { GSYNC();
      const bf16_t* src = (const bf16_t*)(ws + (DUMP_OFF)); for (size_t i = (size_t)bid * 512 + threadIdx.x; i < (size_t)(DUMP_N); i += (size_t)G * 512) p.out[i] = __uint_as_float((unsigned)src[i] << 16); }
#endif
#ifdef DUMPF_OFF
    { GSYNC();
      const float* src = (const float*)(ws + (DUMPF_OFF)); for (size_t i = (size_t)bid * 512 + threadIdx.x; i < (size_t)(DUMPF_N); i += (size_t)G * 512) p.out[i] = src[i]; }
#endif
#undef IN
#undef SYNC
#undef p
}

extern "C" void kernel_launch(void* const* d_in, const int* in_sizes, int n_in, void* d_out, int out_size, void* d_ws, size_t ws_size, hipStream_t stream) {
    static int grid = 0;
    if (grid == 0) {
        if (n_in != 29 || ws_size < W_END) { fprintf(stderr, "kernel_launch: unexpected n_in %d / ws_size %zu (need %zu)\n", n_in, ws_size, (size_t)W_END); grid = -1; return; }
        int dev = 0, cus = 0, per_cu = 0;
        hipGetDevice(&dev); hipDeviceGetAttribute(&cus, hipDeviceAttributeMultiprocessorCount, dev);
        if (hipFuncSetAttribute((const void*)fwd_kernel, hipFuncAttributeMaxDynamicSharedMemorySize, LDS_BYTES) != hipSuccess) { fprintf(stderr, "kernel_launch: hipFuncSetAttribute failed\n"); (void)hipGetLastError(); }
        if (hipOccupancyMaxActiveBlocksPerMultiprocessor(&per_cu, (const void*)fwd_kernel, 512, LDS_BYTES) != hipSuccess || per_cu < 1) { per_cu = 1; (void)hipGetLastError(); }
        if (per_cu > 1) per_cu = 1;
        grid = cus * per_cu;
        if (grid > 256) grid = 256;
    }
    if (grid < 0) return;
    Params p{};
    const float** pp = (const float**)&p;
    for (int i = 0; i < 29; ++i) pp[i] = (const float*)d_in[i];
    p.out = (float*)d_out; p.ws = (unsigned char*)d_ws; p.ph_lo = 0; p.ph_hi = PH_HI;
    (void)hipMemsetAsync((unsigned char*)d_ws + W_BAR, 0, XCD_BAR_WORDS * 4, stream);
    void* args[] = {&p};
    hipError_t e = hipLaunchCooperativeKernel((const void*)fwd_kernel, dim3(grid), dim3(512), args, LDS_BYTES, stream);
    if (e != hipSuccess) fprintf(stderr, "cooperative launch failed: %s (grid %d)\n", hipGetErrorString(e), grid);
}
```

```cpp
#include <hip/hip_runtime.h>
#include <hip/hip_cooperative_groups.h>
#include <cstdio>
#define PH_HI 11
namespace cg = cooperative_groups;

#define LAS __attribute__((address_space(3)))
typedef unsigned short bf16_t;
typedef short bf16x8 __attribute__((ext_vector_type(8)));
typedef float f32x4 __attribute__((ext_vector_type(4)));
typedef unsigned u32x4 __attribute__((ext_vector_type(4)));
typedef unsigned u32x2 __attribute__((ext_vector_type(2)));

constexpr int MTOK = 16896, MPR = 16384, DM = 1024, NPROJ = 1536, FF = 2816, FF2 = 5632;
constexpr int MC16 = 1280, KY = 384;
constexpr float EPS = 1e-6f;
constexpr size_t O_Y = 0, O_VS = 17301504, O_SRP = 17563648, O_SIP = 17580032, O_CP = 17596416, O_SRS = 17686528, O_SIS = 17948672, O_CS = 18210816;
constexpr size_t W_WUP = 0, W_WDN = 11534336, W_HB = 17301504, W_HALO = 51904512, W_UPS = 57851904, W_SSQB = 63619072, W_SSQH = 63686656,
                 W_SSQF = 63754240, W_R1 = 63821824, W_A16 = 63889408, W_AM12 = 63905792, W_SSQA = 63922176, W_BAR = 63989760, W_UP = 64006144;
constexpr size_t W_WIN = W_UP + 0, W_WGLU = W_UP + 3145728, W_WOUT = W_UP + 3670016, W_WTRIL = W_UP + 5767168, W_WY = W_UP + 5898240,
                 W_WE = W_UP + 12189696, W_XB = W_UP + 16384000, W_GB = W_UP + 50987008  , W_U = W_UP + 50987008, W_V = W_UP + 68288512,
                 W_AG = W_UP + 85590016, W_EB = W_UP + 117047296, W_MIX = W_UP + 138018816, W_AOUT = W_UP + 172621824;
constexpr size_t W_ACT = W_UP, W_HEAD = W_UP + 100663296, W_PART = W_UP + 110100480;
constexpr size_t W_END = W_UP + (size_t)MTOK * FF2 * 2;
constexpr int LDS_BYTES = 131072 + 16;

struct Params {
    const float *x_prompt, *x_sample, *st_re, *st_im, *st_conv, *g_mix, *w_in, *g_v, *w_s, *b_s, *lam_re, *lam_im, *log_dt, *b_re, *b_im, *c_re, *c_im,
        *d_skip, *w_glu, *b_glu, *g_out_a, *g_out_b, *w_out, *g_ffn, *w_ffn_in, *conv_w, *conv_b, *w_ffn_out, *g_final;
    float* out; unsigned char* ws; int ph_lo, ph_hi;
};
typedef const __attribute__((address_space(4))) Params* KP;
#define p (*kp)

__device__ __forceinline__ unsigned short f2bf(float f) { unsigned u = __float_as_uint(f); u += 0x7FFFu + ((u >> 16) & 1u); return (unsigned short)(u >> 16); }
__device__ __forceinline__ float bflo(unsigned w) { return __uint_as_float(w << 16); }
__device__ __forceinline__ float bfhi(unsigned w) { return __uint_as_float(w & 0xffff0000u); }
__device__ __forceinline__ unsigned pk2(float lo, float hi) { return (unsigned)f2bf(lo) | ((unsigned)f2bf(hi) << 16); }
__device__ __forceinline__ float gelu_t(float x) { const float z = -2.3022082f * (x + 0.044715f * x * x * x); return x * __builtin_amdgcn_rcpf(1.0f + __builtin_amdgcn_exp2f(z)); }
__device__ __forceinline__ float sigm(float x) { return __builtin_amdgcn_rcpf(1.0f + __builtin_amdgcn_exp2f(-1.44269504f * x)); }
template <int CTRL> __device__ __forceinline__ float dpps(float old, float v) { return __int_as_float(__builtin_amdgcn_update_dpp(__float_as_int(old), __float_as_int(v), CTRL, 0xf, 0xf, false)); }
template <int CTRL> __device__ __forceinline__ float dppf(float v) { return __int_as_float(__builtin_amdgcn_update_dpp(0, __float_as_int(v), CTRL, 0xf, 0xf, false)); }


#define XB_TMO      128
#define XB_XCNT(j)  (256  + 64 * (j))
#define XB_XSUB(j)  (1280 + 64 * (j))
#define XB_XGEN(j)  (2304 + 64 * (j))
#define XB_TOP      3328
#define XB_TOPGEN   3392
#define XCD_BAR_WORDS 3456
#define XB_SPIN_CAP (1u << 18)
__device__ __forceinline__ unsigned xb_ld(unsigned* q)              { return __hip_atomic_load(q, __ATOMIC_RELAXED, __HIP_MEMORY_SCOPE_AGENT); }
__device__ __forceinline__ unsigned xb_add(unsigned* q, unsigned v) { return __hip_atomic_fetch_add(q, v, __ATOMIC_RELAXED, __HIP_MEMORY_SCOPE_AGENT); }
__device__ __forceinline__ unsigned xb_xcc_id() { return (unsigned)__builtin_amdgcn_s_getreg((3 << 11) | 20) & 0xFu; }
#define XB_SPIN(cond, bar) do { unsigned _sp = 0; while (cond) { __builtin_amdgcn_s_sleep(1); \
    if ((++_sp & 255u) == 0u) { if (xb_ld(&(bar)[XB_TMO])) break; if (_sp > XB_SPIN_CAP) { atomicAdd(&(bar)[XB_TMO], 1u); break; } } } } while (0)
__device__ __forceinline__ void xcd_barrier_complete(unsigned* bar, unsigned x, unsigned& nloc, unsigned& nx) {
    const unsigned G = gridDim.x;
    unsigned sum, cnt, mine, sp = 0u;
    for (;;) {
        sum = 0u; cnt = 0u; mine = 0u;
#pragma unroll
        for (unsigned j = 0; j < 16; ++j) { const unsigned c = xb_ld(&bar[XB_XCNT(j)]); sum += c; cnt += (c > 0u) ? 1u : 0u; mine = (j == x) ? c : mine; }
        if (sum == G) break;
        __builtin_amdgcn_s_sleep(1);
        if ((++sp & 255u) == 0u) { if (xb_ld(&bar[XB_TMO])) break; if (sp > XB_SPIN_CAP) { atomicAdd(&bar[XB_TMO], 1u); break; } }
    }
    nloc = mine > 0u ? mine : 1u; nx = cnt > 0u ? cnt : 1u;
}
__device__ __forceinline__ void xcd_barrier(unsigned* bar, volatile LAS unsigned* st) {
    asm volatile("s_waitcnt vmcnt(0)" ::: "memory");
    __syncthreads();
    if (threadIdx.x == 0) {
        __builtin_amdgcn_s_waitcnt(0);
        const unsigned x = xb_xcc_id();
        unsigned nloc = st[0], nx = st[1];
        if (nloc == 0u) { xcd_barrier_complete(bar, x, nloc, nx); st[0] = nloc; st[1] = nx; }
        const unsigned old = xb_add(&bar[XB_XSUB(x)], 1u);
        const unsigned gen = old / nloc;
        if (old + 1u == (gen + 1u) * nloc) {
            __builtin_amdgcn_fence(__ATOMIC_RELEASE, "agent");
            asm volatile("s_waitcnt vmcnt(0)" ::: "memory");
            const unsigned og = xb_add(&bar[XB_TOP], 1u);
            const unsigned tg = og / nx;
            if (og + 1u == (tg + 1u) * nx) xb_add(&bar[XB_TOPGEN], 1u);
            else XB_SPIN(xb_ld(&bar[XB_TOPGEN]) == tg, bar);
            __builtin_amdgcn_fence(__ATOMIC_ACQUIRE, "agent");
            xb_add(&bar[XB_XGEN(x)], 1u);
            asm volatile("s_waitcnt vmcnt(0)" ::: "memory");
        } else {
            XB_SPIN(xb_ld(&bar[XB_XGEN(x)]) == gen, bar);
            __builtin_amdgcn_fence(__ATOMIC_ACQUIRE, "agent");
            asm volatile("s_waitcnt vmcnt(0)" ::: "memory");
        }
    }
    __syncthreads();
}

namespace pg8 {
constexpr int BM = 256, BK = 64, HALF = 128, HTB = HALF * BK * 2, STAGE_BYTES = 8 * HTB, NXCD = 8, WGM = 8;
__device__ __forceinline__ int lds_byte(int r, int c) { const int st = (r >> 4) * 2 + (c >> 5), rr = r & 15, cc = c & 31, ob = rr * 64 + cc * 2; return st * 1024 + (ob ^ (((ob >> 9) & 1) << 5)); }
__device__ __forceinline__ void stage_rc(int b, int& R, int& C) { const int st = b / 1024, sb = b % 1024, swz = sb ^ (((sb >> 9) & 1) << 5); R = (st >> 1) * 16 + swz / 64; C = (st & 1) * 32 + (swz % 64) / 2; }
__device__ __forceinline__ int perm32(int rho) { const int n = rho >> 4, i = rho & 15; return 8 * (i >> 2) + 4 * n + (i & 3); }
struct Unit { int pm, pn, k0, nt; };
struct Gemm { const bf16_t* A; const bf16_t* Bt; int lda, ldb; size_t kstepA, kstepB, tstepA, tstepB; };
__device__ __forceinline__ Gemm gemm_rm(const bf16_t* A, const bf16_t* Bt, int lda, int ldb) { return Gemm{A, Bt, lda, ldb, 128, 128, (size_t)512 * lda, (size_t)512 * ldb}; }
struct StaticOrder {
    int nM, nN, nwg, G, c, ntK;
    __device__ void init(int M, int N, int K, int G_, int c_) { nM = M / BM; nN = N / BM; nwg = nM * nN; G = G_; c = c_; ntK = K / BK; }
    __device__ bool next(int i, Unit& u) const {
        const long L = (long)i * G + c; if (L >= nwg) return false;
        int wgid = (int)L; { const int q = nwg / NXCD, r = nwg % NXCD, xcd = wgid % NXCD, off = wgid / NXCD; wgid = (xcd < r ? xcd * (q + 1) : r * (q + 1) + (xcd - r) * q) + off; }
        const int nig = WGM * nN, gid = wgid / nig, fm = gid * WGM, gsz = (nM - fm) < WGM ? (nM - fm) : WGM;
        u.pm = fm + ((wgid % nig) % gsz); u.pn = (wgid % nig) / gsz; u.k0 = 0; u.nt = ntK; return true;
    }
};
struct BatchedOrder {
    int nu, per, G, c, ntK;
    __device__ bool next(int i, Unit& u) const { int L = i * G + c; if (L >= nu) return false;
        if (G == 256 && nu == 160 && per == 5) { const int x = c & 7, slot = c >> 3; L = (4 * x + slot / 5) * 5 + slot % 5; }
        u.pm = L; u.pn = L / per; u.k0 = 0; u.nt = ntK; return true; }
};
struct SplitOrder {
    StaticOrder S0; int nN, nch, pm0;
    __device__ void init(int Mmain, int N, int K, int G_, int c_) { S0.init(Mmain, N, K, G_, c_); nN = N / BM; nch = K / 256; pm0 = Mmain / BM; }
    __device__ bool next(int i, Unit& u) const {
        if (S0.next(i, u)) return true;
        const int R = ((S0.nwg + S0.G - 1) / S0.G) * S0.G, s = i * S0.G + S0.c - R;
        if (s < 0 || s >= 2 * nN * nch) return false;
        u.pm = pm0 + s / (nN * nch); u.pn = (s / nch) % nN; u.k0 = (s % nch) * 256; u.nt = 4; return true;
    }
};
__device__ __forceinline__ unsigned cvt_pk_bf16(float lo, float hi) { unsigned r; asm volatile("v_cvt_pk_bf16_f32 %0, %1, %2" : "=v"(r) : "v"(lo), "v"(hi)); return r; }
struct NoMid { static constexpr bool ON = false; __device__ __forceinline__ void operator()(f32x4 (&)[2][2][4][2], const Unit&, int, int) const {} };

template <class Epi, class Sched, class Mid>
__device__ __forceinline__ void gemm_phase(LAS unsigned char* lds, const Gemm g, const Sched& S, const Epi& E, const Mid& MD) {
    const int tid = threadIdx.x, wid = __builtin_amdgcn_readfirstlane(tid >> 6), lane = tid & 63, wr = wid >> 2, wc = wid & 3, fr = lane & 15, fq = lane >> 4;
    unsigned voffA[2], voffB[2];
#pragma unroll
    for (int i = 0; i < 2; ++i) { int R, C; stage_rc(tid * 16 + i * 8192, R, C); const int Rb = Epi::PERM ? ((R & ~31) + perm32(R & 31)) : R;
        voffA[i] = (unsigned)(R * g.lda + C) * 2u; voffB[i] = (unsigned)(Rb * g.ldb + C) * 2u; }
    const size_t kstepA = g.kstepA, kstepB = g.kstepB;
    const size_t hstepA = (size_t)HALF * g.lda * 2, hstepB = (size_t)HALF * g.ldb * 2;
    const size_t tstepA = g.tstepA, tstepB = g.tstepB;
    const unsigned ldsw = (unsigned)wid * 1024u;
    const int aoff = lds_byte(wr * 64 + fr, fq * 8), boff = lds_byte(wc * 32 + fr, fq * 8);
#define PG8_SA(b, h) (((b) * 2 + (h)) * HTB)
#define PG8_SB(b, h) ((4 + (b) * 2 + (h)) * HTB)
#define PG8_STAGE(bufoff, gbase, voff) do { _Pragma("unroll") for (int _i = 0; _i < 2; ++_i) \
        __builtin_amdgcn_global_load_lds((const unsigned*)((const char*)(gbase) + (voff)[_i]), (LAS unsigned*)(lds + (bufoff) + ldsw + _i * 8192), 16, 0, 0); } while (0)
#define PG8_LDA(dst, b, h) do { _Pragma("unroll") for (int m = 0; m < 4; ++m) _Pragma("unroll") for (int k = 0; k < 2; ++k) dst[m][k] = *(const LAS bf16x8*)(lds + PG8_SA(b, h) + aoff + m * 2048 + k * 1024); } while (0)
#define PG8_LDB(dst, b, h) do { _Pragma("unroll") for (int n = 0; n < 2; ++n) _Pragma("unroll") for (int k = 0; k < 2; ++k) dst[n][k] = *(const LAS bf16x8*)(lds + PG8_SB(b, h) + boff + n * 2048 + k * 1024); } while (0)
#define PG8_MMA(ai, bj, At, Bt) do { __builtin_amdgcn_s_setprio(1); _Pragma("unroll") for (int m = 0; m < 4; ++m) _Pragma("unroll") for (int n = 0; n < 2; ++n) _Pragma("unroll") for (int k = 0; k < 2; ++k) \
        acc[ai][bj][m][n] = __builtin_amdgcn_mfma_f32_16x16x32_bf16(Bt[n][k], At[m][k], acc[ai][bj][m][n], 0, 0, 0); __builtin_amdgcn_s_setprio(0); } while (0)
#define PG8_WAIT_V(n) asm volatile("s_waitcnt vmcnt(" #n ")" ::: "memory")
#define PG8_WAIT_L(n) asm volatile("s_waitcnt lgkmcnt(" #n ")" ::: "memory")
#define PG8_BAR __builtin_amdgcn_s_barrier()
#define PG8_SCHED __builtin_amdgcn_sched_barrier(0)
    Unit cur, nxt; int ui = 0;
    if (!S.next(0, cur)) return;
    f32x4 acc[2][2][4][2];
#pragma unroll
    for (int a = 0; a < 2; ++a)
#pragma unroll
        for (int b = 0; b < 2; ++b)
#pragma unroll
            for (int m = 0; m < 4; ++m)
#pragma unroll
                for (int n = 0; n < 2; ++n) acc[a][b][m][n] = (f32x4){0.f, 0.f, 0.f, 0.f};
    bf16x8 At[4][2], B0[2][2], B1[2][2];
    const char* cA = (const char*)g.A + (size_t)cur.pm * tstepA + (size_t)(cur.k0 >> 6) * kstepA; const char* cB = (const char*)g.Bt + (size_t)cur.pn * tstepB + (size_t)(cur.k0 >> 6) * kstepB;
    PG8_STAGE(PG8_SB(0, 0), cB, voffB); PG8_STAGE(PG8_SA(0, 0), cA, voffA); PG8_STAGE(PG8_SB(0, 1), cB + hstepB, voffB); PG8_STAGE(PG8_SA(0, 1), cA + hstepA, voffA);
    if (wr == 1) PG8_BAR;
    PG8_WAIT_V(4); PG8_BAR;
    PG8_STAGE(PG8_SB(1, 0), cB + kstepB, voffB); PG8_STAGE(PG8_SA(1, 0), cA + kstepA, voffA); PG8_STAGE(PG8_SB(1, 1), cB + hstepB + kstepB, voffB);
    PG8_WAIT_V(6); PG8_BAR;
    for (;;) {
        const bool has_next = S.next(ui + 1, nxt);
        const char* nA = has_next ? (const char*)g.A + (size_t)nxt.pm * tstepA + (size_t)(nxt.k0 >> 6) * kstepA : cA; const char* nB = has_next ? (const char*)g.Bt + (size_t)nxt.pn * tstepB + (size_t)(nxt.k0 >> 6) * kstepB : cB;
        const int nt = cur.nt;
        for (int t = 0; t < nt; t += 2) {
            const bool last = (t == nt - 2);
            if constexpr (Mid::ON) { if (t == (nt >> 1)) MD(acc, cur, wr, fr); }
            const char* a1 = cA + (size_t)(t + 1) * kstepA;
            const char* a2 = last ? nA : cA + (size_t)(t + 2) * kstepA; const char* b2 = last ? nB : cB + (size_t)(t + 2) * kstepB;
            const char* a3 = a2 + kstepA; const char* b3 = b2 + kstepB;
            PG8_LDB(B0, 0, 0); PG8_SCHED; PG8_LDA(At, 0, 0); PG8_STAGE(PG8_SA(1, 1), a1 + hstepA, voffA);
            PG8_WAIT_L(8); PG8_BAR; PG8_WAIT_L(0); PG8_MMA(0, 0, At, B0); PG8_BAR; PG8_SCHED;
            PG8_LDB(B1, 0, 1); PG8_STAGE(PG8_SB(0, 0), b2, voffB);
            PG8_BAR; PG8_WAIT_L(0); PG8_MMA(0, 1, At, B1); PG8_BAR;
            PG8_LDA(At, 0, 1); PG8_STAGE(PG8_SA(0, 0), a2, voffA);
            PG8_BAR; PG8_WAIT_L(0); PG8_MMA(1, 0, At, B0); PG8_BAR; PG8_SCHED;
            PG8_STAGE(PG8_SB(0, 1), b2 + hstepB, voffB);
            PG8_WAIT_V(6); PG8_BAR; PG8_MMA(1, 1, At, B1); PG8_BAR;
            PG8_LDB(B0, 1, 0); PG8_SCHED; PG8_LDA(At, 1, 0); PG8_STAGE(PG8_SA(0, 1), a2 + hstepA, voffA);
            PG8_WAIT_L(8); PG8_BAR; PG8_WAIT_L(0); PG8_MMA(0, 0, At, B0); PG8_BAR; PG8_SCHED;
            PG8_LDB(B1, 1, 1); PG8_STAGE(PG8_SB(1, 0), b3, voffB);
            PG8_BAR; PG8_WAIT_L(0); PG8_MMA(0, 1, At, B1); PG8_BAR;
            PG8_LDA(At, 1, 1); PG8_STAGE(PG8_SA(1, 0), a3, voffA);
            PG8_BAR; PG8_WAIT_L(0); PG8_MMA(1, 0, At, B0); PG8_BAR; PG8_SCHED;
            PG8_STAGE(PG8_SB(1, 1), b3 + hstepB, voffB);
            PG8_WAIT_V(6); PG8_BAR; PG8_MMA(1, 1, At, B1); PG8_BAR;
        }
        E(acc, cur, wr, wc, fr, fq);
        if (!has_next) break;
#pragma unroll
        for (int a = 0; a < 2; ++a)
#pragma unroll
            for (int b = 0; b < 2; ++b)
#pragma unroll
                for (int m = 0; m < 4; ++m)
#pragma unroll
                    for (int n = 0; n < 2; ++n) acc[a][b][m][n] = (f32x4){0.f, 0.f, 0.f, 0.f};
        cur = nxt; cA = nA; cB = nB; ++ui;
    }
    PG8_WAIT_V(0);
    if (wr == 0) PG8_BAR;
    PG8_BAR;
#undef PG8_SA
#undef PG8_SB
#undef PG8_STAGE
#undef PG8_LDA
#undef PG8_LDB
#undef PG8_MMA
#undef PG8_WAIT_V
#undef PG8_WAIT_L
#undef PG8_BAR
#undef PG8_SCHED
}
}
using pg8::Unit;
typedef f32x4 Acc[2][2][4][2];
__device__ __forceinline__ size_t act_off(int r, int j) { return ((size_t)((r >> 8) * (FF / 64) + (j >> 6)) * 256 + (r & 255)) * 64 + (j & 63); }

struct EpiProj { static constexpr bool PERM = true; const float* r1; bf16_t* U; bf16_t* V; bf16_t* AG;
    __device__ __forceinline__ void operator()(const Acc& acc, const Unit& u, int wr, int wc, int fr, int fq) const {
        const int row0 = u.pm * 256 + wr * 64 + fr, colt = u.pn * 256 + wc * 32 + 8 * fq;
#pragma unroll
        for (int ai = 0; ai < 2; ++ai)
#pragma unroll
            for (int m = 0; m < 4; ++m) { const int r = row0 + ai * 128 + m * 16; const float s = r1[r];
#pragma unroll
                for (int bj = 0; bj < 2; ++bj) { const int c = colt + bj * 128; const f32x4 v0 = acc[ai][bj][m][0] * s, v1 = acc[ai][bj][m][1] * s;
                    u32x4 w; w.x = pg8::cvt_pk_bf16(v0[0], v0[1]); w.y = pg8::cvt_pk_bf16(v0[2], v0[3]); w.z = pg8::cvt_pk_bf16(v1[0], v1[1]); w.w = pg8::cvt_pk_bf16(v1[2], v1[3]);
                    bf16_t* dst;
                    if (u.pn < 2) dst = U + (size_t)r * 512 + c;
                    else if (u.pn < 4) dst = V + (size_t)r * 512 + (c - 512);
                    else { const int ch = c - 1024, gg = ch >> 4, ci0 = ch & 15; int c16, t; if (r < MPR) { c16 = r >> 4; t = r & 15; } else { c16 = 1024 + ((r - MPR) >> 2); t = 12 + (r & 3); }
                        dst = AG + ((size_t)(gg * MC16 + c16) * KY + t * 16 + ci0); }
                    *(u32x4*)dst = w; } }
    }
};
struct EpiE { static constexpr bool PERM = false; float* EB;
    __device__ __forceinline__ void operator()(const Acc& acc, const Unit& u, int wr, int wc, int fr, int fq) const {
        const int row0 = u.pm * 256 + wr * 64 + fr, col0 = wc * 32 + 4 * fq;
#pragma unroll
        for (int ai = 0; ai < 2; ++ai)
#pragma unroll
            for (int m = 0; m < 4; ++m) { float* rp = EB + (size_t)(row0 + ai * 128 + m * 16) * 128 + col0;
#pragma unroll
                for (int n = 0; n < 2; ++n) *(f32x4*)(rp + n * 16) = acc[ai][0][m][n]; }
    }
};
struct EpiY { static constexpr bool PERM = true; const bf16_t* AG; const float* dsk; bf16_t* GB;
    __device__ __forceinline__ void operator()(const Acc& acc, const Unit& u, int wr, int wc, int fr, int fq) const {
        asm volatile("" : "+v"(fr), "+v"(fq));
        const int gg = u.pn, row0 = u.pm * 256 + wr * 64 + fr, colt = wc * 32 + 8 * fq;
#pragma unroll
        for (int ai = 0; ai < 2; ++ai)
#pragma unroll
            for (int m = 0; m < 4; ++m) { const int r = row0 + ai * 128 + m * 16, c16 = r - gg * MC16;
#pragma unroll
                for (int bj = 0; bj < 2; ++bj) { const int cb = colt + bj * 128, t = cb >> 4, co0 = cb & 15;
                    int tok = -1; if (c16 < 1024) tok = c16 * 16 + t; else if (c16 < 1152 && t >= 12) tok = MPR + (c16 - 1024) * 4 + (t - 12);
                    if (tok >= 0) {
                        const u32x4 xw = *(const u32x4*)(AG + (size_t)r * KY + cb);
                        u32x4 w;
                        { const f32x4 d0 = *(const f32x4*)(dsk + gg * 16 + co0); const f32x4 a0 = acc[ai][bj][m][0];
                          w.x = pg8::cvt_pk_bf16(gelu_t(a0[0] + d0[0] * bflo(xw.x)), gelu_t(a0[1] + d0[1] * bfhi(xw.x))); w.y = pg8::cvt_pk_bf16(gelu_t(a0[2] + d0[2] * bflo(xw.y)), gelu_t(a0[3] + d0[3] * bfhi(xw.y))); }
                        { const f32x4 d1 = *(const f32x4*)(dsk + gg * 16 + co0 + 4); const f32x4 a1 = acc[ai][bj][m][1];
                          w.z = pg8::cvt_pk_bf16(gelu_t(a1[0] + d1[0] * bflo(xw.z)), gelu_t(a1[1] + d1[1] * bfhi(xw.z))); w.w = pg8::cvt_pk_bf16(gelu_t(a1[2] + d1[2] * bflo(xw.w)), gelu_t(a1[3] + d1[3] * bfhi(xw.w))); }
                        *(u32x4*)(GB + (size_t)tok * 512 + gg * 16 + co0) = w; } }
                asm volatile("" ::: "memory"); }
    }
};
struct EpiGlu { static constexpr bool PERM = true; const bf16_t* GB; const float* bglu; bf16_t* MIX; float* ssq;
    __device__ __forceinline__ void operator()(const Acc& acc, const Unit& u, int wr, int wc, int fr, int fq) const {
        const int row0 = u.pm * 256 + wr * 64 + fr, colt = u.pn * 256 + wc * 32 + 8 * fq;
#pragma unroll
        for (int ai = 0; ai < 2; ++ai)
#pragma unroll
            for (int m = 0; m < 4; ++m) { const int r = row0 + ai * 128 + m * 16; float sq = 0.f;
#pragma unroll
                for (int bj = 0; bj < 2; ++bj) { const int c = colt + bj * 128;
                    const u32x4 gw = *(const u32x4*)(GB + (size_t)r * 512 + c);
                    const f32x4 b0 = *(const f32x4*)(bglu + c), b1 = *(const f32x4*)(bglu + c + 4);
                    const f32x4 a0 = acc[ai][bj][m][0] + b0, a1 = acc[ai][bj][m][1] + b1;
                    float o[8]; o[0] = bflo(gw.x) * sigm(a0[0]); o[1] = bfhi(gw.x) * sigm(a0[1]); o[2] = bflo(gw.y) * sigm(a0[2]); o[3] = bfhi(gw.y) * sigm(a0[3]);
                    o[4] = bflo(gw.z) * sigm(a1[0]); o[5] = bfhi(gw.z) * sigm(a1[1]); o[6] = bflo(gw.w) * sigm(a1[2]); o[7] = bfhi(gw.w) * sigm(a1[3]);
#pragma unroll
                    for (int e = 0; e < 8; ++e) sq += o[e] * o[e];
                    u32x4 w; w.x = pg8::cvt_pk_bf16(o[0], o[1]); w.y = pg8::cvt_pk_bf16(o[2], o[3]); w.z = pg8::cvt_pk_bf16(o[4], o[5]); w.w = pg8::cvt_pk_bf16(o[6], o[7]);
                    *(u32x4*)(MIX + (size_t)r * 1024 + c) = w; }
                sq += __shfl_xor(sq, 16); sq += __shfl_xor(sq, 32);
                if (fq == 0) atomicAdd(ssq + r, sq); }
    }
};
struct MidOut { static constexpr bool ON = true; const float* ssqb;
    __device__ __forceinline__ void operator()(Acc& acc, const Unit& u, int wr, int fr) const {
        if (u.nt != 16) return;
        const int row0 = u.pm * 256 + wr * 64 + fr;
#pragma unroll
        for (int ai = 0; ai < 2; ++ai)
#pragma unroll
            for (int m = 0; m < 4; ++m) { const float s = rsqrtf(ssqb[row0 + ai * 128 + m * 16] * (1.0f / 512.0f) + EPS);
#pragma unroll
                for (int bj = 0; bj < 2; ++bj)
#pragma unroll
                    for (int n = 0; n < 2; ++n) acc[ai][bj][m][n] *= s; }
    }
};
struct EpiOut { static constexpr bool PERM = true; const float* xp; const float* xs; float* H; bf16_t* HB; float* ssq; const float* ssqb; float* PART; const bf16_t* XB;
    __device__ __forceinline__ void operator()(const Acc& acc, const Unit& u, int wr, int wc, int fr, int fq) const {
        const int row0 = u.pm * 256 + wr * 64 + fr, colt = u.pn * 256 + wc * 32 + 8 * fq;
        if (u.nt != 16) {
#pragma unroll
            for (int ai = 0; ai < 2; ++ai)
#pragma unroll
                for (int m = 0; m < 4; ++m) { const int r = row0 + ai * 128 + m * 16; const float s = (u.k0 < 512) ? rsqrtf(ssqb[r] * (1.0f / 512.0f) + EPS) : 1.0f;
#pragma unroll
                    for (int bj = 0; bj < 2; ++bj) { float* q = PART + ((size_t)(u.k0 >> 8) * 512 + (r - MPR)) * 1024 + colt + bj * 128;
                        *(f32x4*)q = acc[ai][bj][m][0] * s; *(f32x4*)(q + 4) = acc[ai][bj][m][1] * s; } }
            return;
        }
#pragma unroll
        for (int ai = 0; ai < 2; ++ai)
#pragma unroll
            for (int m = 0; m < 4; ++m) { const int r = row0 + ai * 128 + m * 16; float sq = 0.f;
#pragma unroll
                for (int bj = 0; bj < 2; ++bj) { const int c = colt + bj * 128;
                    const u32x4 xw = *(const u32x4*)(XB + (size_t)r * 1024 + c);
                    const f32x4 h0 = (f32x4){bflo(xw.x), bfhi(xw.x), bflo(xw.y), bfhi(xw.y)} + acc[ai][bj][m][0], h1 = (f32x4){bflo(xw.z), bfhi(xw.z), bflo(xw.w), bfhi(xw.w)} + acc[ai][bj][m][1];
                    sq += h0[0] * h0[0] + h0[1] * h0[1] + h0[2] * h0[2] + h0[3] * h0[3] + h1[0] * h1[0] + h1[1] * h1[1] + h1[2] * h1[2] + h1[3] * h1[3];
                    u32x4 w; w.x = pg8::cvt_pk_bf16(h0[0], h0[1]); w.y = pg8::cvt_pk_bf16(h0[2], h0[3]); w.z = pg8::cvt_pk_bf16(h1[0], h1[1]); w.w = pg8::cvt_pk_bf16(h1[2], h1[3]);
                    *(u32x4*)(HB + (size_t)r * 1024 + c) = w; }
                sq += __shfl_xor(sq, 16); sq += __shfl_xor(sq, 32);
                if (fq == 0) atomicAdd(ssq + r, sq); }
    }
};
struct EpiUp { static constexpr bool PERM = true; const float* ssqh; bf16_t* ACT; bf16_t* HALO; bf16_t* HEAD; bf16_t* UPS; float* out; const float* cw; const float* cb;
    __device__ __forceinline__ void operator()(Acc& acc, const Unit& u, int wr, int wc, int fr, int fq) const {
        const int row0 = u.pm * 256 + wr * 64 + fr, j0 = u.pn * 128 + wc * 32 + 8 * fq;
#pragma unroll
        for (int ai = 0; ai < 2; ++ai)
#pragma unroll
            for (int m = 0; m < 4; ++m) { const float s = rsqrtf(ssqh[row0 + ai * 128 + m * 16] * (1.0f / 1024.0f) + EPS);
#pragma unroll
                for (int bj = 0; bj < 2; ++bj)
#pragma unroll
                    for (int n = 0; n < 2; ++n) acc[ai][bj][m][n] *= s; }
        if (u.pm >= 64) {
#pragma unroll
            for (int ai = 0; ai < 2; ++ai)
#pragma unroll
                for (int m = 0; m < 4; ++m) { const int rs = row0 + ai * 128 + m * 16 - MPR, j = rs & 3;
#pragma unroll
                    for (int bj = 0; bj < 2; ++bj) { const f32x4 v0 = acc[ai][bj][m][0], v1 = acc[ai][bj][m][1]; const int c = bj * FF + j0;
                        u32x4 w; w.x = pg8::cvt_pk_bf16(v0[0], v0[1]); w.y = pg8::cvt_pk_bf16(v0[2], v0[3]); w.z = pg8::cvt_pk_bf16(v1[0], v1[1]); w.w = pg8::cvt_pk_bf16(v1[2], v1[3]);
                        *(u32x4*)(UPS + (size_t)rs * FF2 + c) = w;
                        if (j >= 2) { float* o = out + O_CS + ((size_t)((rs >> 2) * 2 + (j - 2))) * FF2 + c; __builtin_nontemporal_store(v0, (f32x4*)o); __builtin_nontemporal_store(v1, (f32x4*)(o + 4)); } } }
            return;
        }
#pragma unroll
        for (int ai = 0; ai < 2; ++ai) { const int rb = row0 + ai * 128;
            if (fr >= 14) { const int r = rb + 48, k = r >> 6, pos = r & 2047;
#pragma unroll
                for (int bj = 0; bj < 2; ++bj) { const f32x4 v0 = acc[ai][bj][3][0], v1 = acc[ai][bj][3][1]; const int c = bj * FF + j0;
                    u32x4 w; w.x = pg8::cvt_pk_bf16(v0[0], v0[1]); w.y = pg8::cvt_pk_bf16(v0[2], v0[3]); w.z = pg8::cvt_pk_bf16(v1[0], v1[1]); w.w = pg8::cvt_pk_bf16(v1[2], v1[3]);
                    *(u32x4*)(HALO + (size_t)(k * 2 + (fr - 14)) * FF2 + c) = w;
                    if (pos >= 2046) { float* o = out + O_CP + ((size_t)((r >> 11) * 2 + (pos - 2046))) * FF2 + c; __builtin_nontemporal_store(v0, (f32x4*)o); __builtin_nontemporal_store(v1, (f32x4*)(o + 4)); } } }
            if (fr < 2) { const int k = rb >> 6;
#pragma unroll
                for (int bj = 0; bj < 2; ++bj) { const f32x4 v0 = acc[ai][bj][0][0], v1 = acc[ai][bj][0][1]; const int c = bj * FF + j0;
                    u32x4 w; w.x = pg8::cvt_pk_bf16(v0[0], v0[1]); w.y = pg8::cvt_pk_bf16(v0[2], v0[3]); w.z = pg8::cvt_pk_bf16(v1[0], v1[1]); w.w = pg8::cvt_pk_bf16(v1[2], v1[3]);
                    *(u32x4*)(HEAD + (size_t)(k * 2 + fr) * FF2 + c) = w; } } }
        u32x2 keep[2][4];
#pragma unroll
        for (int n = 0; n < 2; ++n) { const int j = j0 + 4 * n;
            const f32x4 wg0 = *(const f32x4*)(cw + j), wg1 = *(const f32x4*)(cw + FF2 + j), wg2 = *(const f32x4*)(cw + 2 * FF2 + j), bg = *(const f32x4*)(cb + j);
            const f32x4 wv0 = *(const f32x4*)(cw + FF + j), wv1 = *(const f32x4*)(cw + FF2 + FF + j), wv2 = *(const f32x4*)(cw + 2 * FF2 + FF + j), bv = *(const f32x4*)(cb + FF + j);
#pragma unroll
            for (int ai = 0; ai < 2; ++ai)
#pragma unroll
                for (int m = 0; m < 4; ++m) { const f32x4 cg = acc[ai][0][m][n], cv = acc[ai][1][m][n];
                    const f32x4 pg = acc[ai][0][m > 0 ? m - 1 : 0][n], pv = acc[ai][1][m > 0 ? m - 1 : 0][n];
                    f32x4 g1, g2, v1, v2;
#pragma unroll
                    for (int e = 0; e < 4; ++e) {
                        g1[e] = dpps<0x111>(dppf<0x121>(pg[e]), cg[e]); g2[e] = dpps<0x112>(dppf<0x122>(pg[e]), cg[e]);
                        v1[e] = dpps<0x111>(dppf<0x121>(pv[e]), cv[e]); v2[e] = dpps<0x112>(dppf<0x122>(pv[e]), cv[e]); }
                    const f32x4 ga = bg + wg0 * g2 + wg1 * g1 + wg2 * cg, va = bv + wv0 * v2 + wv1 * v1 + wv2 * cv;
                    const f32x4 zz = (ga + ga * ga * ga * 0.044715f) * (-2.3022082f);
                    f32x4 o;
#pragma unroll
                    for (int e = 0; e < 4; ++e) o[e] = __builtin_amdgcn_rcpf(1.0f + __builtin_amdgcn_exp2f(zz[e]));
                    o = o * ga * va;
                    u32x2 w; w.x = pg8::cvt_pk_bf16(o[0], o[1]); w.y = pg8::cvt_pk_bf16(o[2], o[3]);
                    if (n == 0) keep[ai][m] = w;
                    else { u32x4 w4; w4.x = keep[ai][m].x; w4.y = keep[ai][m].y; w4.z = w.x; w4.w = w.y; *(u32x4*)(ACT + act_off(row0 + ai * 128 + m * 16, j0)) = w4; asm volatile("" ::: "memory"); } } }
    }
};
struct EpiDown { static constexpr bool PERM = true; float* H; float* ssq; const bf16_t* HB; float* PART; bf16_t* HBW;
    __device__ __forceinline__ void operator()(const Acc& acc, const Unit& u, int wr, int wc, int fr, int fq) const {
        const int row0 = u.pm * 256 + wr * 64 + fr, colt = u.pn * 256 + wc * 32 + 8 * fq;
        const bool partial = (u.nt != FF / 64);
#pragma unroll
        for (int ai = 0; ai < 2; ++ai)
#pragma unroll
            for (int m = 0; m < 4; ++m) { const int r = row0 + ai * 128 + m * 16; float sq = 0.f;
#pragma unroll
                for (int bj = 0; bj < 2; ++bj) { const int c = colt + bj * 128; f32x4 h0 = acc[ai][bj][m][0], h1 = acc[ai][bj][m][1];
                    if (!partial || u.k0 == 0) { const u32x4 hw = *(const u32x4*)(HB + (size_t)r * 1024 + c);
                        h0 += (f32x4){bflo(hw.x), bfhi(hw.x), bflo(hw.y), bfhi(hw.y)}; h1 += (f32x4){bflo(hw.z), bfhi(hw.z), bflo(hw.w), bfhi(hw.w)}; }
                    if (partial) { float* q = PART + ((size_t)(u.k0 >> 8) * 512 + (r - MPR)) * 1024 + c; *(f32x4*)q = h0; *(f32x4*)(q + 4) = h1; }
                    else { sq += h0[0] * h0[0] + h0[1] * h0[1] + h0[2] * h0[2] + h0[3] * h0[3] + h1[0] * h1[0] + h1[1] * h1[1] + h1[2] * h1[2] + h1[3] * h1[3];
                        u32x4 w; w.x = pg8::cvt_pk_bf16(h0[0], h0[1]); w.y = pg8::cvt_pk_bf16(h0[2], h0[3]); w.z = pg8::cvt_pk_bf16(h1[0], h1[1]); w.w = pg8::cvt_pk_bf16(h1[2], h1[3]);
                        *(u32x4*)(HBW + (size_t)r * 1024 + c) = w; } }
                if (!partial) { sq += __shfl_xor(sq, 16); sq += __shfl_xor(sq, 32); if (fq == 0) atomicAdd(ssq + r, sq); } }
    }
};

__device__ __forceinline__ void tr_tile(const float* src, int N, int k0, int n0, bf16_t* dst, int ldd, int kd0, const float* sc, LAS float* tile, int tid, int dn0 = -1) {
    if (dn0 < 0) dn0 = n0;
    { const int tr = tid >> 5, tc = tid & 31; float4 v[4];
#pragma unroll
      for (int i = 0; i < 4; ++i) { const f32x4 a_ = __builtin_nontemporal_load((const f32x4*)(src + (size_t)(k0 + tr + i * 16) * N + n0 + tc * 4)); v[i] = make_float4(a_[0], a_[1], a_[2], a_[3]); }
#pragma unroll
      for (int i = 0; i < 4; ++i) { const int k = tr + i * 16; const float s = sc ? sc[k] : 1.0f;
          tile[k * 129 + tc * 4 + 0] = v[i].x * s; tile[k * 129 + tc * 4 + 1] = v[i].y * s; tile[k * 129 + tc * 4 + 2] = v[i].z * s; tile[k * 129 + tc * 4 + 3] = v[i].w * s; } }
    __syncthreads();
#pragma unroll
    for (int h = 0; h < 2; ++h) { const int wn = (tid >> 3) + h * 64, wk = tid & 7; float e[8];
#pragma unroll
      for (int j = 0; j < 8; ++j) e[j] = tile[(wk * 8 + j) * 129 + wn];
      u32x4 w; w.x = pk2(e[0], e[1]); w.y = pk2(e[2], e[3]); w.z = pk2(e[4], e[5]); w.w = pk2(e[6], e[7]);
      *(u32x4*)(dst + (size_t)(dn0 + wn) * ldd + kd0 + wk * 8) = w; }
    __syncthreads();
}

__device__ __forceinline__ void ssm_prep(KP kp, int g, int half, LAS float* L, int tid) {
    LAS float* apr = L;
    LAS float* api = L + 17 * 64;
    LAS float* bbr = L + 2 * 17 * 64;
    LAS float* bbi = bbr + 1024;
    LAS float* crr = bbi + 1024;
    LAS float* cii = crr + 1024;
    LAS float* frs = cii + 1024;
    LAS float* fis = frs + 64;
    LAS float* ktau = fis + 64;
    unsigned char* ws = p.ws;
    if (tid < 64) {
        const float dt = expf(p.log_dt[g]); const float lr = p.lam_re[g * 64 + tid], li = p.lam_im[g * 64 + tid];
        const float mag = expf(lr * dt), ang = li * dt; const float ar = mag * cosf(ang), ai = mag * sinf(ang);
        const float den = lr * lr + li * li;
        frs[tid] = ((ar - 1.0f) * lr + ai * li) / den; fis[tid] = (ai * lr - (ar - 1.0f) * li) / den;
        float pr = 1.f, pi = 0.f;
        for (int t = 0; t <= 16; ++t) { apr[t * 64 + tid] = pr; api[t * 64 + tid] = pi; const float nr = pr * ar - pi * ai, ni = pr * ai + pi * ar; pr = nr; pi = ni; }
        if (half == 0) { ((float*)(ws + W_A16))[g * 64 + tid] = apr[16 * 64 + tid]; ((float*)(ws + W_A16))[2048 + g * 64 + tid] = api[16 * 64 + tid]; }
        const float m2 = ar * ar + ai * ai; const float ir = ar / m2, ii = -ai / m2; float qr = 1.f, qi = 0.f;
        for (int t = 0; t < 12; ++t) { const float nr = qr * ir - qi * ii, ni = qr * ii + qi * ir; qr = nr; qi = ni; }
        if (half == 0) { ((float*)(ws + W_AM12))[g * 64 + tid] = qr; ((float*)(ws + W_AM12))[2048 + g * 64 + tid] = qi; }
    }
    for (int i = tid; i < 1024; i += 512) { crr[i] = p.c_re[g * 1024 + i]; cii[i] = p.c_im[g * 1024 + i]; }
    __syncthreads();
    for (int i = tid; i < 1024; i += 512) { const int pp = i >> 4; const float br = p.b_re[g * 1024 + i], bi = p.b_im[g * 1024 + i];
        bbr[i] = frs[pp] * br - fis[pp] * bi; bbi[i] = frs[pp] * bi + fis[pp] * br; }
    __syncthreads();
    for (int i2 = tid; i2 < 2048; i2 += 512) { const int tau = i2 >> 7, co = half * 8 + ((i2 >> 4) & 7), ci = i2 & 15, i = tau * 256 + co * 16 + ci; float s = 0.f;
        for (int pp = 0; pp < 64; ++pp) { const float cr = crr[co * 64 + pp], cim = cii[co * 64 + pp], pr = apr[tau * 64 + pp], pi = api[tau * 64 + pp];
            const float xr = cr * pr - cim * pi, xi = cr * pi + cim * pr; s += xr * bbr[pp * 16 + ci] - xi * bbi[pp * 16 + ci]; }
        ktau[i] = s; }
    __syncthreads();
    bf16_t* WY = (bf16_t*)(ws + W_WY) + (size_t)g * 256 * KY;
    for (int i = tid; i < 128 * 48; i += 512) { const int n2 = i / 48, k0 = (i % 48) * 8, t = n2 >> 3, co = half * 8 + (n2 & 7), n = t * 16 + co; float e[8];
        if (k0 < 256) { const int s = k0 >> 4, ci0 = k0 & 15;
#pragma unroll
            for (int j = 0; j < 8; ++j) e[j] = (t >= s) ? ktau[(t - s) * 256 + co * 16 + ci0 + j] : 0.f; }
        else { const int kk = k0 - 256, ri = kk >> 6, p0 = kk & 63;
#pragma unroll
            for (int j = 0; j < 8; ++j) { const int pp = p0 + j; const float cr = crr[co * 64 + pp], cim = cii[co * 64 + pp], pr = apr[(t + 1) * 64 + pp], pi = api[(t + 1) * 64 + pp];
                e[j] = ri == 0 ? (cr * pr - cim * pi) : -(cr * pi + cim * pr); } }
        u32x4 w; w.x = pk2(e[0], e[1]); w.y = pk2(e[2], e[3]); w.z = pk2(e[4], e[5]); w.w = pk2(e[6], e[7]);
        *(u32x4*)(WY + (size_t)n * KY + k0) = w; }
    bf16_t* WE = (bf16_t*)(ws + W_WE) + (size_t)g * 256 * 256;
    for (int i = tid; i < 64 * 32; i += 512) { const int ri = half, pp = i >> 5, n = ri * 64 + pp, k0 = (i & 31) * 8, s = k0 >> 4, ci0 = k0 & 15; float e[8];
        const float pr = apr[(15 - s) * 64 + pp], pi = api[(15 - s) * 64 + pp];
#pragma unroll
        for (int j = 0; j < 8; ++j) { const float br = bbr[pp * 16 + ci0 + j], bi = bbi[pp * 16 + ci0 + j]; e[j] = ri == 0 ? (pr * br - pi * bi) : (pr * bi + pi * br); }
        u32x4 w; w.x = pk2(e[0], e[1]); w.y = pk2(e[2], e[3]); w.z = pk2(e[4], e[5]); w.w = pk2(e[6], e[7]);
        *(u32x4*)(WE + (size_t)n * 256 + k0) = w; }
    __syncthreads();
}

__device__ __forceinline__ void tr_do(KP kp, LAS float* tile, int tid, int ti) {
    unsigned char* ws = p.ws;
    if (ti < 192) { const int kt = ti / 12, nt = ti % 12; tr_tile(p.w_in, NPROJ, kt * 64, nt * 128, (bf16_t*)(ws + W_WIN), 1024, kt * 64, p.g_mix + kt * 64, tile, tid); }
    else if (ti < 224) { const int t2 = ti - 192, kt = t2 / 4, nt = t2 % 4; tr_tile(p.w_glu, 512, kt * 64, nt * 128, (bf16_t*)(ws + W_WGLU), 512, kt * 64, nullptr, tile, tid); }
    else if (ti < 352) { const int t2 = ti - 224, kt = t2 / 8, nt = t2 % 8; const int k0 = kt * 64;
        tr_tile(p.w_out, 1024, k0, nt * 128, (bf16_t*)(ws + W_WOUT), 1024, (k0 + 512) & 1023, k0 < 512 ? p.g_out_a + k0 : p.g_out_b + (k0 - 512), tile, tid); }
    else if (ti < 1056) { const int t2 = ti - 352, kt = t2 / 44, nt = t2 % 44; const int jn = nt * 128, hb = jn >= FF ? 1 : 0, jj = jn - hb * FF;
        tr_tile(p.w_ffn_in, FF2, kt * 64, jn, (bf16_t*)(ws + W_WUP), 1024, kt * 64, p.g_ffn + kt * 64, tile, tid, (jj >> 7) * 256 + hb * 128); }
    else { const int t2 = ti - 1056, kt = t2 / 8, nt = t2 % 8, n0 = nt * 128;
        tr_tile(p.w_ffn_out, 1024, kt * 64, n0, (bf16_t*)(ws + W_WDN), 64, 0, nullptr, tile, tid, ((n0 >> 8) * (FF / 64) + kt) * 256 + (n0 & 255)); }
}
__device__ __forceinline__ void tr_range(KP kp, LAS unsigned char* lds, int lo, int hi, int idx, int stride) {
    __syncthreads();
    for (int ti = lo + idx; ti < hi; ti += stride) tr_do(kp, (LAS float*)lds, threadIdx.x, ti);
}

__device__ __forceinline__ void phase0(KP kp, LAS unsigned char* lds) {
    const int tid = threadIdx.x, bid = blockIdx.x, G = gridDim.x, lane = tid & 63, wid = tid >> 6;
    unsigned char* ws = p.ws;
    { const int gt = bid * 512 + tid, GT = G * 512;
      float* z = (float*)(ws + W_SSQB); for (int i = gt; i < 3 * MTOK; i += GT) z[i] = 0.f;
      float* za = (float*)(ws + W_SSQA); for (int i = gt; i < MTOK; i += GT) za[i] = 0.f;
      bf16_t* wt = (bf16_t*)(ws + W_WTRIL); for (int i = gt; i < 65536; i += GT) { const int t = (i >> 7) & 127, s = i & 127; wt[i] = f2bf(s <= t ? p.w_s[i] : 0.f); }
      unsigned* ag = (unsigned*)(ws + W_AG);
      for (int i = gt; i < 32 * 128 * 96; i += GT) { const int gg = i / (128 * 96), rem = i % (128 * 96), b = rem / 96, k2 = rem % 96; ag[((size_t)(gg * MC16 + 1024 + b) * KY) / 2 + k2] = 0u; } }
    { bf16_t* XB = (bf16_t*)(ws + W_XB); float* R1 = (float*)(ws + W_R1);
      for (int row = (bid * 8 + wid) * 2; row < MTOK; row += G * 16) {
          float4 v[2][4]; float sq[2] = {0.f, 0.f};
#pragma unroll
          for (int rr = 0; rr < 2; ++rr) { const int r = row + rr; const float* src = r < MPR ? p.x_prompt + (size_t)r * 1024 : p.x_sample + (size_t)(r - MPR) * 1024;
#pragma unroll
              for (int i = 0; i < 2; ++i) { const f32x4 a_ = __builtin_nontemporal_load((const f32x4*)(src + i * 512 + lane * 8)), b_ = __builtin_nontemporal_load((const f32x4*)(src + i * 512 + lane * 8 + 4));
                  v[rr][2 * i] = make_float4(a_[0], a_[1], a_[2], a_[3]); v[rr][2 * i + 1] = make_float4(b_[0], b_[1], b_[2], b_[3]); } }
#pragma unroll
          for (int rr = 0; rr < 2; ++rr) {
#pragma unroll
              for (int i = 0; i < 4; ++i) sq[rr] += v[rr][i].x * v[rr][i].x + v[rr][i].y * v[rr][i].y + v[rr][i].z * v[rr][i].z + v[rr][i].w * v[rr][i].w;
#pragma unroll
              for (int o = 32; o >= 1; o >>= 1) sq[rr] += __shfl_xor(sq[rr], o);
              if (lane == 0) R1[row + rr] = rsqrtf(sq[rr] * (1.0f / 1024.0f) + EPS);
#pragma unroll
              for (int i = 0; i < 2; ++i) { u32x4 w; w.x = pk2(v[rr][2 * i].x, v[rr][2 * i].y); w.y = pk2(v[rr][2 * i].z, v[rr][2 * i].w); w.z = pk2(v[rr][2 * i + 1].x, v[rr][2 * i + 1].y); w.w = pk2(v[rr][2 * i + 1].z, v[rr][2 * i + 1].w);
                  *(u32x4*)(XB + (size_t)(row + rr) * 1024 + i * 512 + lane * 8) = w; } } } }
    LAS float* tile = (LAS float*)lds;
    for (int ti = bid; ti < 192; ti += G) tr_do(kp, tile, tid, ti);
}

__device__ __forceinline__ void sgu_phase(KP kp, LAS unsigned char* lds, int first_item_offset) {
    const int tid = threadIdx.x, G = gridDim.x, lane = tid & 63, wid = tid >> 6, fr = lane & 15, fq = lane >> 4;
    unsigned char* ws = p.ws;
    const bf16_t* U = (const bf16_t*)(ws + W_U); const bf16_t* V = (const bf16_t*)(ws + W_V); const bf16_t* WT = (const bf16_t*)(ws + W_WTRIL);
    bf16_t* AOUT = (bf16_t*)(ws + W_AOUT); float* SSQA = (float*)(ws + W_SSQA);
    LAS bf16_t* vnT = (LAS bf16_t*)lds;
    const bool free_wg = (G == 256) && ((int)blockIdx.x >= first_item_offset);
    const int it0 = (G == 256) ? (free_wg ? (int)blockIdx.x - first_item_offset : 384 + (int)blockIdx.x) : (int)blockIdx.x;
    const int itstep = (G == 256) ? (free_wg ? G - first_item_offset : 1024) : G, itend = (G == 256 && free_wg) ? 384 : 516;
    for (int item = it0; item < itend; item += itstep) {
        if (item < 512) {
            const int t0 = (item >> 2) * 128, tb = wid, trow = tb * 16 + fr;
            float sq = 0.f;
            { const int h = item & 3;
                const int nk = (tb >> 1) + 1; bf16x8 wfr[4];
#pragma unroll
                for (int ks = 0; ks < 4; ++ks) if (ks < nk) wfr[ks] = *(const bf16x8*)(WT + (size_t)(h * 128 + trow) * 128 + ks * 32 + fq * 8);
                { const int row = tid >> 2, q = tid & 3; const bf16_t* vp = V + (size_t)(t0 + row) * 512 + h * 128 + q * 32;
                  u32x4 w[4]; float s2 = 0.f;
#pragma unroll
                  for (int i = 0; i < 4; ++i) { w[i] = *(const u32x4*)(vp + i * 8);
                      const float a0 = bflo(w[i].x), a1 = bfhi(w[i].x), a2 = bflo(w[i].y), a3 = bfhi(w[i].y), a4 = bflo(w[i].z), a5 = bfhi(w[i].z), a6 = bflo(w[i].w), a7 = bfhi(w[i].w);
                      s2 += a0 * a0 + a1 * a1 + a2 * a2 + a3 * a3 + a4 * a4 + a5 * a5 + a6 * a6 + a7 * a7; }
                  s2 += __shfl_xor(s2, 1); s2 += __shfl_xor(s2, 2);
                  const float rs = rsqrtf(s2 * (1.0f / 128.0f) + EPS); const float* gv = p.g_v + h * 128 + q * 32;
#pragma unroll
                  for (int i = 0; i < 4; ++i) { const unsigned ww[4] = {w[i].x, w[i].y, w[i].z, w[i].w};
#pragma unroll
                      for (int j = 0; j < 4; ++j) { const int d = q * 32 + i * 8 + j * 2;
                          vnT[d * 136 + row] = f2bf(bflo(ww[j]) * rs * gv[i * 8 + j * 2]); vnT[(d + 1) * 136 + row] = f2bf(bfhi(ww[j]) * rs * gv[i * 8 + j * 2 + 1]); } } }
                __syncthreads();
                f32x4 acc[8];
#pragma unroll
                for (int db = 0; db < 8; ++db) acc[db] = (f32x4){0.f, 0.f, 0.f, 0.f};
#pragma unroll
                for (int ks = 0; ks < 4; ++ks) if (ks < nk) {
                    const bf16x8 wf = wfr[ks];
#pragma unroll
                    for (int db = 0; db < 8; ++db) { const bf16x8 xf = *(const LAS bf16x8*)(vnT + (db * 16 + fr) * 136 + ks * 32 + fq * 8);
                        acc[db] = __builtin_amdgcn_mfma_f32_16x16x32_bf16(xf, wf, acc[db], 0, 0, 0); }
                }
                const float bs = p.b_s[h * 128 + trow];
#pragma unroll
                for (int db = 0; db < 8; ++db) { const u32x2 uw = *(const u32x2*)(U + (size_t)(t0 + trow) * 512 + h * 128 + db * 16 + 4 * fq);
                    const float a0 = bflo(uw.x) * (acc[db][0] + bs), a1 = bfhi(uw.x) * (acc[db][1] + bs), a2 = bflo(uw.y) * (acc[db][2] + bs), a3 = bfhi(uw.y) * (acc[db][3] + bs);
                    sq += a0 * a0 + a1 * a1 + a2 * a2 + a3 * a3; u32x2 w; w.x = pk2(a0, a1); w.y = pk2(a2, a3);
                    *(u32x2*)(AOUT + (size_t)(t0 + trow) * 512 + h * 128 + db * 16 + 4 * fq) = w;
#ifdef SGU_DIRECT
                    *(f32x4*)((float*)(ws + W_HB) + (size_t)(t0 + trow) * 512 + h * 128 + db * 16 + 4 * fq) = (f32x4){a0, a1, a2, a3};
#endif
 }
                __syncthreads();
            }
            sq += __shfl_xor(sq, 16); sq += __shfl_xor(sq, 32);
            if (fq == 0) atomicAdd(SSQA + t0 + trow, sq);
        } else {
            const int sc = item - 512, sqn = tid >> 4, h = (tid >> 2) & 3, dq = tid & 3, b = sc * 32 + sqn, row0 = MPR + b * 4;
            float rs[4];
#pragma unroll
            for (int j = 0; j < 4; ++j) { const bf16_t* vp = V + (size_t)(row0 + j) * 512 + h * 128 + dq * 32; float s2 = 0.f;
#pragma unroll
                for (int i = 0; i < 4; ++i) { const u32x4 w = *(const u32x4*)(vp + i * 8); const unsigned ww[4] = {w.x, w.y, w.z, w.w};
#pragma unroll
                    for (int k = 0; k < 4; ++k) { const float a = bflo(ww[k]), c = bfhi(ww[k]); s2 += a * a + c * c; } }
                s2 += __shfl_xor(s2, 1); s2 += __shfl_xor(s2, 2); rs[j] = rsqrtf(s2 * (1.0f / 128.0f) + EPS); }
            float wsj[4][4], bsj[4];
#pragma unroll
            for (int j = 0; j < 4; ++j) { bsj[j] = p.b_s[h * 128 + j];
#pragma unroll
                for (int k = 0; k < 4; ++k) wsj[j][k] = (k <= j) ? p.w_s[(size_t)(h * 128 + j) * 128 + k] : 0.f; }
            float ssa[4] = {0.f, 0.f, 0.f, 0.f};
            { const int sweep = 0;
                for (int i = 0; i < 4; ++i) { const int d0 = dq * 32 + i * 8; float vn[4][8];
#pragma unroll
                    for (int j = 0; j < 4; ++j) { const u32x4 w = *(const u32x4*)(V + (size_t)(row0 + j) * 512 + h * 128 + d0); const unsigned ww[4] = {w.x, w.y, w.z, w.w};
#pragma unroll
                        for (int k = 0; k < 4; ++k) { vn[j][2 * k] = bflo(ww[k]) * rs[j] * p.g_v[h * 128 + d0 + 2 * k]; vn[j][2 * k + 1] = bfhi(ww[k]) * rs[j] * p.g_v[h * 128 + d0 + 2 * k + 1]; }
                        if (sweep == 0) { float* o = p.out + O_VS + ((size_t)((b * 4 + j) * 4 + h)) * 128 + d0;
                            *(f32x4*)o = (f32x4){vn[j][0], vn[j][1], vn[j][2], vn[j][3]}; *(f32x4*)(o + 4) = (f32x4){vn[j][4], vn[j][5], vn[j][6], vn[j][7]}; } }
#pragma unroll
                    for (int j = 0; j < 4; ++j) { const u32x4 uw = *(const u32x4*)(U + (size_t)(row0 + j) * 512 + h * 128 + d0); const unsigned uu[4] = {uw.x, uw.y, uw.z, uw.w}; float a[8];
#pragma unroll
                        for (int e = 0; e < 8; ++e) { float s = bsj[j];
#pragma unroll
                            for (int k = 0; k < 4; ++k) s += wsj[j][k] * vn[k][e];
                            const float uv = (e & 1) ? bfhi(uu[e >> 1]) : bflo(uu[e >> 1]); a[e] = uv * s; }
#pragma unroll
                        for (int e = 0; e < 8; ++e) ssa[j] += a[e] * a[e];
                        { u32x4 w; w.x = pk2(a[0], a[1]); w.y = pk2(a[2], a[3]); w.z = pk2(a[4], a[5]); w.w = pk2(a[6], a[7]);
                            *(u32x4*)(AOUT + (size_t)(row0 + j) * 512 + h * 128 + d0) = w; } } }
#pragma unroll
                for (int j = 0; j < 4; ++j) { float s = ssa[j]; s += __shfl_xor(s, 1); s += __shfl_xor(s, 2); s += __shfl_xor(s, 4); s += __shfl_xor(s, 8); if ((tid & 15) == 0) SSQA[row0 + j] = s; }
            }
        }
    }
}

__device__ __forceinline__ void scan_phase(KP kp) {
    unsigned char* ws = p.ws; const float* EB = (const float*)(ws + W_EB); bf16_t* AG = (bf16_t*)(ws + W_AG);
    const float* A16 = (const float*)(ws + W_A16); const float* AM12 = (const float*)(ws + W_AM12);
    const int GT = gridDim.x * 512;
    for (int id = blockIdx.x * 512 + threadIdx.x; id < 16384 * 8; id += GT) {
        const int seg = id & 7, sid = id >> 3, b = sid >> 11, gp = sid & 2047, gg = gp >> 6, pp = gp & 63; const float ar = A16[gp], ai = A16[2048 + gp];
        const size_t rbase = (size_t)gg * MC16 + b * 128 + seg * 16;
        float er[16], ei[16];
#pragma unroll
        for (int k = 0; k < 16; ++k) { er[k] = EB[(rbase + k) * 128 + pp]; ei[k] = EB[(rbase + k) * 128 + 64 + pp]; }
        float hr = 0.f, hi = 0.f;
#pragma unroll
        for (int k = 0; k < 16; ++k) { const float nr = ar * hr - ai * hi + er[k], ni = ar * hi + ai * hr + ei[k]; hr = nr; hi = ni; }
        float mr = ar, mi = ai;
#pragma unroll
        for (int q = 0; q < 4; ++q) { const float nr = mr * mr - mi * mi, ni = 2.f * mr * mi; mr = nr; mi = ni; }
#pragma unroll
        for (int d = 1; d < 8; d <<= 1) {
            const float hpr = __shfl_up(hr, d, 8), hpi = __shfl_up(hi, d, 8), mpr = __shfl_up(mr, d, 8), mpi = __shfl_up(mi, d, 8);
            if (seg >= d) { const float nhr = hr + mr * hpr - mi * hpi, nhi = hi + mr * hpi + mi * hpr, nmr = mr * mpr - mi * mpi, nmi = mr * mpi + mi * mpr; hr = nhr; hi = nhi; mr = nmr; mi = nmi; } }
        float cr = __shfl_up(hr, 1, 8), ci = __shfl_up(hi, 1, 8); if (seg == 0) { cr = 0.f; ci = 0.f; }
#pragma unroll
        for (int k = 0; k < 16; ++k) { bf16_t* hp = AG + (rbase + k) * KY + 256 + pp; hp[0] = f2bf(cr); hp[64] = f2bf(ci);
            const float nr = ar * cr - ai * ci + er[k], ni = ar * ci + ai * cr + ei[k]; cr = nr; ci = ni; }
        if (seg == 7) { p.out[O_SRP + sid] = cr; p.out[O_SIP + sid] = ci; }
    }
    for (int id = 16384 + blockIdx.x * 512 + threadIdx.x; id < (8 + 128) * 2048; id += GT) {
        if (false) {
        } else { const int id2 = id - 16384, b = id2 >> 11, gp = id2 & 2047, gg = gp >> 6, pp = gp & 63;
            const float sr = p.st_re[id2], si = p.st_im[id2], qr = AM12[gp], qi = AM12[2048 + gp];
            const float hr = sr * qr - si * qi, hi = sr * qi + si * qr; const size_t row = (size_t)gg * MC16 + 1024 + b;
            bf16_t* hp = AG + row * KY + 256 + pp; hp[0] = f2bf(hr); hp[64] = f2bf(hi);
            const float ar = A16[gp], ai = A16[2048 + gp];
            p.out[O_SRS + id2] = ar * hr - ai * hi + EB[row * 128 + pp]; p.out[O_SIS + id2] = ar * hi + ai * hr + EB[row * 128 + 64 + pp]; }
    }
    { bf16_t* MIX = (bf16_t*)(ws + W_MIX); const bf16_t* AOUT = (const bf16_t*)(ws + W_AOUT); const float* SSQA = (const float*)(ws + W_SSQA);
      for (int i = blockIdx.x * 512 + threadIdx.x; i < MTOK * 64; i += GT) { const int r = i >> 6, c = (i & 63) * 8; const float ra = rsqrtf(SSQA[r] * (1.0f / 512.0f) + EPS);
          u32x4* mp = (u32x4*)(MIX + (size_t)r * 1024 + 512 + c); const u32x4 o = *(const u32x4*)(AOUT + (size_t)r * 512 + c); u32x4 w;
          w.x = pk2(bflo(o.x) * ra, bfhi(o.x) * ra); w.y = pk2(bflo(o.y) * ra, bfhi(o.y) * ra); w.z = pk2(bflo(o.z) * ra, bfhi(o.z) * ra); w.w = pk2(bflo(o.w) * ra, bfhi(o.w) * ra); *mp = w; } }
}

__device__ __forceinline__ void ld8bf(const bf16_t* q, float (&o)[8]) { const u32x4 w = *(const u32x4*)q; o[0] = bflo(w.x); o[1] = bfhi(w.x); o[2] = bflo(w.y); o[3] = bfhi(w.y); o[4] = bflo(w.z); o[5] = bfhi(w.z); o[6] = bflo(w.w); o[7] = bfhi(w.w); }
__device__ __forceinline__ void ld8f(const float* q, float (&o)[8]) { const f32x4 a = *(const f32x4*)q, b = *(const f32x4*)(q + 4); o[0] = a[0]; o[1] = a[1]; o[2] = a[2]; o[3] = a[3]; o[4] = b[0]; o[5] = b[1]; o[6] = b[2]; o[7] = b[3]; }
__device__ __forceinline__ void act_phase(KP kp) {
    unsigned char* ws = p.ws; bf16_t* ACT = (bf16_t*)(ws + W_ACT); const bf16_t* HALO = (const bf16_t*)(ws + W_HALO); const bf16_t* HEAD = (const bf16_t*)(ws + W_HEAD); const bf16_t* UPS = (const bf16_t*)(ws + W_UPS);
    const int GT = gridDim.x * 512, gt = blockIdx.x * 512 + threadIdx.x;
    const float* cw = p.conv_w; const float* cb = p.conv_b;
    for (int e = gt; e < (512 + 512) * 352; e += GT) {
        const int rowi = e / 352, col = (e % 352) * 8;
        float ga[8], va[8], t[8], w[8]; int orow;
        ld8f(cb + col, ga); ld8f(cb + FF + col, va);
        if (rowi < 512) { const int k = rowi >> 1, rr = rowi & 1; const bool hist = ((k * 64) & 2047) != 0; orow = k * 64 + rr;
#pragma unroll
            for (int q = 0; q < 3; ++q) { const int idx = rr + q - 2; const bf16_t* src = nullptr;
                if (idx >= 0) src = HEAD + (size_t)(k * 2 + idx) * FF2 + col; else if (hist) src = HALO + (size_t)((k - 1) * 2 + idx + 2) * FF2 + col;
                if (src) { ld8bf(src, t); ld8f(cw + q * FF2 + col, w);
#pragma unroll
                    for (int i = 0; i < 8; ++i) ga[i] += w[i] * t[i];
                    ld8bf(src + FF, t); ld8f(cw + q * FF2 + FF + col, w);
#pragma unroll
                    for (int i = 0; i < 8; ++i) va[i] += w[i] * t[i]; } } }
        else { const int rs = rowi - 512, b = rs >> 2, j = rs & 3; orow = MPR + rs;
#pragma unroll
            for (int q = 0; q < 3; ++q) { const int idx = j + q - 2;
                if (idx >= 0) { const bf16_t* src = UPS + (size_t)(b * 4 + idx) * FF2 + col; ld8bf(src, t); ld8f(cw + q * FF2 + col, w);
#pragma unroll
                    for (int i = 0; i < 8; ++i) ga[i] += w[i] * t[i];
                    ld8bf(src + FF, t); ld8f(cw + q * FF2 + FF + col, w);
#pragma unroll
                    for (int i = 0; i < 8; ++i) va[i] += w[i] * t[i]; }
                else { const float* src = p.st_conv + (size_t)(b * 2 + idx + 2) * FF2 + col; ld8f(src, t); ld8f(cw + q * FF2 + col, w);
#pragma unroll
                    for (int i = 0; i < 8; ++i) ga[i] += w[i] * t[i];
                    ld8f(src + FF, t); ld8f(cw + q * FF2 + FF + col, w);
#pragma unroll
                    for (int i = 0; i < 8; ++i) va[i] += w[i] * t[i]; } } }
        u32x4 o; o.x = pk2(gelu_t(ga[0]) * va[0], gelu_t(ga[1]) * va[1]); o.y = pk2(gelu_t(ga[2]) * va[2], gelu_t(ga[3]) * va[3]);
        o.z = pk2(gelu_t(ga[4]) * va[4], gelu_t(ga[5]) * va[5]); o.w = pk2(gelu_t(ga[6]) * va[6], gelu_t(ga[7]) * va[7]);
        *(u32x4*)(ACT + act_off(orow, col)) = o;
    }
}

__device__ __forceinline__ void final_phase(KP kp) {
    const float* ssq = (const float*)(p.ws + W_SSQF); const int GT = gridDim.x * 512;
    for (int i = blockIdx.x * 512 + threadIdx.x; i < MPR * 128; i += GT) { const int r = i >> 7, c = (i & 127) * 8;
        const float s = rsqrtf(ssq[r] * (1.0f / 1024.0f) + EPS); float* hp = p.out + (size_t)r * 1024 + c; const f32x4 g0 = *(const f32x4*)(p.g_final + c), g1 = *(const f32x4*)(p.g_final + c + 4);
        const u32x4 hw = __builtin_nontemporal_load((const u32x4*)((const bf16_t*)(p.ws + W_HB) + (size_t)r * 1024 + c));
        __builtin_nontemporal_store((f32x4){bflo(hw.x), bfhi(hw.x), bflo(hw.y), bfhi(hw.y)} * s * g0, (f32x4*)hp); __builtin_nontemporal_store((f32x4){bflo(hw.z), bfhi(hw.z), bflo(hw.w), bfhi(hw.w)} * s * g1, (f32x4*)(hp + 4)); }
    const int lane = threadIdx.x & 63, wv = blockIdx.x * 8 + (threadIdx.x >> 6);
    const float* PART = (const float*)(p.ws + W_PART);
    for (int r = MPR + wv; r < MTOK; r += gridDim.x * 8) { f32x4* hp = (f32x4*)(p.out + (size_t)r * 1024); f32x4 v[4]; float sq = 0.f;
#pragma unroll
        for (int i = 0; i < 4; ++i) { v[i] = (f32x4){0.f, 0.f, 0.f, 0.f};
            for (int kc = 0; kc < 11; ++kc) v[i] += ((const f32x4*)(PART + ((size_t)kc * 512 + (r - MPR)) * 1024))[lane + i * 64];
            sq += v[i][0] * v[i][0] + v[i][1] * v[i][1] + v[i][2] * v[i][2] + v[i][3] * v[i][3]; }
#pragma unroll
        for (int o = 32; o >= 1; o >>= 1) sq += __shfl_xor(sq, o);
        const float s = rsqrtf(sq * (1.0f / 1024.0f) + EPS);
#pragma unroll
        for (int i = 0; i < 4; ++i) hp[lane + i * 64] = v[i] * s * ((const f32x4*)p.g_final)[lane + i * 64]; }
}

__global__ void __launch_bounds__(512, 2) fwd_kernel(Params p_unused) {
    extern __shared__ __attribute__((aligned(16))) unsigned char shm[];
    KP kp = (KP)__builtin_amdgcn_kernarg_segment_ptr();
    LAS unsigned char* lds = (LAS unsigned char*)shm;
    cg::grid_group grid = cg::this_grid();
    unsigned char* ws = p.ws; const int G = gridDim.x, bid = blockIdx.x;
    const int lo = p.ph_lo, hi = p.ph_hi;
    if (threadIdx.x < 2) ((volatile LAS unsigned*)(lds + 131072))[threadIdx.x] = 0u;
    __syncthreads();
    if (threadIdx.x == 0) (void)xb_add(&((unsigned*)(p.ws + W_BAR))[XB_XCNT(xb_xcc_id())], 1u);
    if (lo < 0) grid.sync();
    const int cid = bid;
#ifndef PHMASK
#define PHMASK 0x7ff
#endif
#define IN(k) (((PHMASK >> (k)) & 1) && lo <= (k) && (k) < hi)
#define GSYNC() xcd_barrier((unsigned*)(p.ws + W_BAR), (volatile LAS unsigned*)(lds + 131072))
#define SYNC(k) do { if (IN(k) && IN((k) + 1)) GSYNC(); } while (0)
    if (IN(0)) { phase0(kp, lds); } SYNC(0);
    if (IN(1)) { pg8::Gemm g = pg8::gemm_rm((const bf16_t*)(ws + W_XB), (const bf16_t*)(ws + W_WIN), 1024, 1024); pg8::StaticOrder S; S.init(MTOK, NPROJ, 1024, G, cid);
        EpiProj E{(const float*)(ws + W_R1), (bf16_t*)(ws + W_U), (bf16_t*)(ws + W_V), (bf16_t*)(ws + W_AG)};
        pg8::gemm_phase(lds, g, S, E, pg8::NoMid{});
        if (cid >= G - 64) { __syncthreads(); ssm_prep(kp, (cid - (G - 64)) >> 1, (cid - (G - 64)) & 1, (LAS float*)lds, threadIdx.x); }
        else if (cid >= 140) tr_range(kp, lds, 1056, 1408, cid - 140, G - 64 - 140); } SYNC(1);
    if (IN(2)) { { pg8::Gemm g = pg8::gemm_rm((const bf16_t*)(ws + W_AG), (const bf16_t*)(ws + W_WE), KY, 256); pg8::BatchedOrder S{160, 5, G, bid, 4}; EpiE E{(float*)(ws + W_EB)};
          pg8::gemm_phase(lds, g, S, E, pg8::NoMid{}); }
        __syncthreads();
        sgu_phase(kp, lds, 160); } SYNC(2);
    if (IN(3)) { scan_phase(kp); tr_range(kp, lds, 192, 352, bid, G); } SYNC(3);
    if (IN(4)) { pg8::Gemm g = pg8::gemm_rm((const bf16_t*)(ws + W_AG), (const bf16_t*)(ws + W_WY), KY, KY); pg8::BatchedOrder S{160, 5, G, bid, 6};
        EpiY E{(const bf16_t*)(ws + W_AG), p.d_skip, (bf16_t*)(ws + W_GB)};
        pg8::gemm_phase(lds, g, S, E, pg8::NoMid{});
        if (bid >= 160) tr_range(kp, lds, 352, 1056, bid - 160, G - 160); } SYNC(4);
    if (IN(5)) { pg8::Gemm g = pg8::gemm_rm((const bf16_t*)(ws + W_GB), (const bf16_t*)(ws + W_WGLU), 512, 512); pg8::StaticOrder S; S.init(MTOK, 512, 512, G, cid);
        EpiGlu E{(const bf16_t*)(ws + W_GB), p.b_glu, (bf16_t*)(ws + W_MIX), (float*)(ws + W_SSQB)};
        pg8::gemm_phase(lds, g, S, E, pg8::NoMid{}); } SYNC(5);
    if (IN(6)) { pg8::Gemm g = pg8::gemm_rm((const bf16_t*)(ws + W_MIX), (const bf16_t*)(ws + W_WOUT), 1024, 1024); pg8::SplitOrder S; S.init(MPR, 1024, 1024, G, cid);
        EpiOut E{p.x_prompt, p.x_sample, p.out, (bf16_t*)(ws + W_HB), (float*)(ws + W_SSQH), (const float*)(ws + W_SSQB), (float*)(ws + W_PART), (const bf16_t*)(ws + W_XB)}; MidOut MD{(const float*)(ws + W_SSQB)};
        pg8::gemm_phase(lds, g, S, E, MD);
        GSYNC();
        {
            const int lane = threadIdx.x & 63; const float* PART = (const float*)(ws + W_PART); bf16_t* HB = (bf16_t*)(ws + W_HB); float* SSQH = (float*)(ws + W_SSQH);
            for (int rs = bid * 8 + (threadIdx.x >> 6); rs < 512; rs += G * 8) { float sq = 0.f;
#pragma unroll
                for (int i = 0; i < 4; ++i) { f32x4 v = ((const f32x4*)(p.x_sample + (size_t)rs * 1024))[lane + i * 64];
#pragma unroll
                    for (int kc = 0; kc < 4; ++kc) v += ((const f32x4*)(PART + ((size_t)kc * 512 + rs) * 1024))[lane + i * 64];
                    sq += v[0] * v[0] + v[1] * v[1] + v[2] * v[2] + v[3] * v[3];
                    u32x2 w; w.x = pk2(v[0], v[1]); w.y = pk2(v[2], v[3]); ((u32x2*)(HB + (size_t)(MPR + rs) * 1024))[lane + i * 64] = w; }
#pragma unroll
                for (int o = 32; o >= 1; o >>= 1) sq += __shfl_xor(sq, o);
                if (lane == 0) SSQH[MPR + rs] = sq; } } } SYNC(6);
    if (IN(7)) { pg8::Gemm g = pg8::gemm_rm((const bf16_t*)(ws + W_HB), (const bf16_t*)(ws + W_WUP), 1024, 1024); pg8::StaticOrder S; S.init(MTOK, FF2, 1024, G, cid);
        EpiUp E{(const float*)(ws + W_SSQH), (bf16_t*)(ws + W_ACT), (bf16_t*)(ws + W_HALO), (bf16_t*)(ws + W_HEAD), (bf16_t*)(ws + W_UPS), p.out, p.conv_w, p.conv_b};
        pg8::gemm_phase(lds, g, S, E, pg8::NoMid{}); } SYNC(7);
    if (IN(8)) { act_phase(kp); } SYNC(8);
    if (IN(9)) { pg8::Gemm g{(const bf16_t*)(ws + W_ACT), (const bf16_t*)(ws + W_WDN), 64, 64, 32768, 32768, (size_t)32768 * (FF / 64), (size_t)32768 * (FF / 64)}; pg8::SplitOrder S; S.init(MPR, 1024, FF, G, cid);
        EpiDown E{p.out, (float*)(ws + W_SSQF), (const bf16_t*)(ws + W_HB), (float*)(ws + W_PART), (bf16_t*)(ws + W_HB)};
        pg8::gemm_phase(lds, g, S, E, pg8::NoMid{}); } SYNC(9);
    if (IN(10)) { final_phase(kp); }
#ifdef DUMP_OFF
    { GSYNC();
      const bf16_t* src = (const bf16_t*)(ws + (DUMP_OFF)); for (size_t i = (size_t)bid * 512 + threadIdx.x; i < (size_t)(DUMP_N); i += (size_t)G * 512) p.out[i] = __uint_as_float((unsigned)src[i] << 16); }
#endif
#ifdef DUMPF_OFF
    { GSYNC();
      const float* src = (const float*)(ws + (DUMPF_OFF)); for (size_t i = (size_t)bid * 512 + threadIdx.x; i < (size_t)(DUMPF_N); i += (size_t)G * 512) p.out[i] = src[i]; }
#endif
#undef IN
#undef SYNC
#undef p
}

extern "C" void kernel_launch(void* const* d_in, const int* in_sizes, int n_in, void* d_out, int out_size, void* d_ws, size_t ws_size, hipStream_t stream) {
    static int grid = 0;
    if (grid == 0) {
        if (n_in != 29 || ws_size < W_END) { fprintf(stderr, "kernel_launch: unexpected n_in %d / ws_size %zu (need %zu)\n", n_in, ws_size, (size_t)W_END); grid = -1; return; }
        int dev = 0, cus = 0, per_cu = 0;
        hipGetDevice(&dev); hipDeviceGetAttribute(&cus, hipDeviceAttributeMultiprocessorCount, dev);
        if (hipFuncSetAttribute((const void*)fwd_kernel, hipFuncAttributeMaxDynamicSharedMemorySize, LDS_BYTES) != hipSuccess) { fprintf(stderr, "kernel_launch: hipFuncSetAttribute failed\n"); (void)hipGetLastError(); }
        if (hipOccupancyMaxActiveBlocksPerMultiprocessor(&per_cu, (const void*)fwd_kernel, 512, LDS_BYTES) != hipSuccess || per_cu < 1) { per_cu = 1; (void)hipGetLastError(); }
        if (per_cu > 1) per_cu = 1;
        grid = cus * per_cu;
        if (grid > 256) grid = 256;
    }
    if (grid < 0) return;
    Params p{};
    const float** pp = (const float**)&p;
    for (int i = 0; i < 29; ++i) pp[i] = (const float*)d_in[i];
    p.out = (float*)d_out; p.ws = (unsigned char*)d_ws; p.ph_lo = 0; p.ph_hi = PH_HI;
    (void)hipMemsetAsync((unsigned char*)d_ws + W_BAR, 0, XCD_BAR_WORDS * 4, stream);
    void* args[] = {&p};
    hipError_t e = hipLaunchCooperativeKernel((const void*)fwd_kernel, dim3(grid), dim3(512), args, LDS_BYTES, stream);
    if (e != hipSuccess) fprintf(stderr, "cooperative launch failed: %s (grid %d)\n", hipGetErrorString(e), grid);
}
```
